# Optimizing an MI355X kernel written in HIP

```python
import jax, jax.numpy as jnp
from jax import lax
import numpy as np

D_MODEL = 1024
BATCH = 1
SEQ = 16384
DEPTH = 1
DEC_BATCH = 16
DEC_SEQ = 64
PAST_LEN = 2048

CHUNK = 64
D_RNN = D_MODEL
N_LRU_BLOCKS = 16
LRU_BLOCK = D_RNN // N_LRU_BLOCKS
CONV_WIDTH = 4
LRU_C = 8.0
N_HEADS = 16
HEAD_DIM = 64
D_ATT = N_HEADS * HEAD_DIM
Q_BLOCK = 128
D_FF = ((8 * D_MODEL // 3 + 255) // 256) * 256
EPS = 1e-6
D_IN = 2 * D_RNN + 3 * D_ATT + 2 * D_MODEL + N_HEADS
SPLIT_POINTS = (D_RNN, 2 * D_RNN, 2 * D_RNN + D_ATT, 2 * D_RNN + 2 * D_ATT, 2 * D_RNN + 3 * D_ATT, 2 * D_RNN + 3 * D_ATT + 2 * D_MODEL)

kernel_name = "hybrid_rglru_fox_stream_step"


def rmsnorm(x, g):
    xf = x.astype(jnp.float32)
    y = xf * lax.rsqrt(jnp.mean(xf * xf, axis=-1, keepdims=True) + EPS)
    return (y * g.astype(jnp.float32)).astype(x.dtype)


def causal_dwconv(x, buf, w, b):
    t = x.shape[1]
    xp = jnp.concatenate([buf.astype(x.dtype), x], axis=1)
    out = b
    for j in range(CONV_WIDTH):
        out = out + xp[:, j:j + t] * w[j]
    return out.astype(x.dtype), xp[:, -(CONV_WIDTH - 1):]


def rg_lru(x, h0, w_rg, b_rg, w_ig, b_ig, lam, reset_first):
    f32 = jnp.float32
    bsz, t, _ = x.shape
    xb = x.reshape(bsz, t, N_LRU_BLOCKS, LRU_BLOCK)
    r = jax.nn.sigmoid((jnp.einsum('bthi,hij->bthj', xb, w_rg).reshape(bsz, t, D_RNN) + b_rg).astype(f32))
    i = jax.nn.sigmoid((jnp.einsum('bthi,hij->bthj', xb, w_ig).reshape(bsz, t, D_RNN) + b_ig).astype(f32))
    log_a = LRU_C * r * jax.nn.log_sigmoid(lam.astype(f32))
    a = jnp.exp(log_a)
    mult = jnp.sqrt(-jnp.expm1(2.0 * log_a))
    if reset_first:
        mult = mult.at[:, 0].set(1.0)
    bterm = mult * i * x.astype(f32)
    bterm = bterm.at[:, 0].add(a[:, 0] * h0.astype(f32))

    def combine(left, right):
        a_l, b_l = left
        a_r, b_r = right
        return a_l * a_r, a_r * b_l + b_r

    _, h = lax.associative_scan(combine, (a, bterm), axis=1)
    return h.astype(x.dtype), h[:, -1]


def fox_attend(qb, cq, q_pos, k, v, ck, k_pos):
    s = jnp.einsum('bqhd,bkhd->bhqk', qb, k).astype(jnp.float32) * (HEAD_DIM ** -0.5)
    bias = jnp.transpose(cq, (0, 2, 1))[:, :, :, None] - jnp.transpose(ck, (0, 2, 1))[:, :, None, :]
    allowed = k_pos[None, None, None, :] <= q_pos[None, None, :, None]
    s = jnp.where(allowed, s + bias, -jnp.inf)
    p = jax.nn.softmax(s, axis=-1)
    return jnp.einsum('bhqk,bkhd->bqhd', p.astype(v.dtype), v)


def layer(x, conv_buf, h0, past_k, past_v, past_logf, norm_mix, w_in, b_forget, b_gate, conv_w, conv_b,
          w_rg, b_rg, w_ig, b_ig, lru_lambda, w_br_lru, w_br_att, w_out, norm_ffn, w_ffn_in, w_ffn_out):
    f32 = jnp.float32
    bsz, t, _ = x.shape
    xn = rmsnorm(x, norm_mix)
    proj = xn @ w_in
    x_rnn, gate_rnn, q, k, v, g_logit, f_logit = jnp.split(proj, SPLIT_POINTS, axis=-1)

    xc, new_buf = causal_dwconv(x_rnn, conv_buf, conv_w, conv_b)
    h_seq, h_last = rg_lru(xc, h0, w_rg, b_rg, w_ig, b_ig, lru_lambda, past_k is None)
    y_lru = h_seq * jax.nn.gelu(gate_rnn)

    q = q.reshape(bsz, t, N_HEADS, HEAD_DIM)
    k = k.reshape(bsz, t, N_HEADS, HEAD_DIM)
    v = v.reshape(bsz, t, N_HEADS, HEAD_DIM)
    logf = jax.nn.log_sigmoid((f_logit + b_forget).astype(f32))
    if past_k is None:
        c = jnp.cumsum(logf, axis=1)
        pos = jnp.arange(t, dtype=jnp.int32)
        nb = t // Q_BLOCK
        qs = jnp.moveaxis(q.reshape(bsz, nb, Q_BLOCK, N_HEADS, HEAD_DIM), 1, 0)
        cs = jnp.moveaxis(c.reshape(bsz, nb, Q_BLOCK, N_HEADS), 1, 0)
        ps = pos.reshape(nb, Q_BLOCK)

        def blk(args):
            qb, cqb, pb = args
            return fox_attend(qb, cqb, pb, k, v, c, pos)

        o = lax.map(blk, (qs, cs, ps))
        y_att = jnp.moveaxis(o, 0, 1).reshape(bsz, t, D_ATT)
    else:
        p_len = past_k.shape[1]
        k_all = jnp.concatenate([past_k.astype(k.dtype), k], axis=1)
        v_all = jnp.concatenate([past_v.astype(v.dtype), v], axis=1)
        c_all = jnp.cumsum(jnp.concatenate([past_logf.astype(f32), logf], axis=1), axis=1)
        q_pos = p_len + jnp.arange(t, dtype=jnp.int32)
        k_pos = jnp.arange(p_len + t, dtype=jnp.int32)
        y_att = fox_attend(q, c_all[:, p_len:], q_pos, k_all, v_all, c_all, k_pos).reshape(bsz, t, D_ATT)

    g = jax.nn.sigmoid((g_logit + b_gate).astype(f32))
    g_lru, g_att = jnp.split(g, [D_MODEL], axis=-1)
    mixed = g_lru * (y_lru @ w_br_lru).astype(f32) + g_att * (y_att @ w_br_att).astype(f32)
    x = x + mixed.astype(x.dtype) @ w_out

    xn2 = rmsnorm(x, norm_ffn)
    gf, up = jnp.split(xn2 @ w_ffn_in, [D_FF], axis=-1)
    x = x + (jax.nn.silu(gf) * up) @ w_ffn_out
    return x, k, v, logf.astype(x.dtype), new_buf, h_last.astype(x.dtype)


def setup_inputs(seed: int = 0) -> dict:
    key = jax.random.key(seed)
    ks = jax.random.split(key, 28)
    nrm = jax.random.normal
    L = DEPTH
    u = jax.random.uniform(ks[13], (L, D_RNN), minval=0.9, maxval=0.999)
    a_base = u ** (1.0 / LRU_C)
    lru_lambda = jnp.log(a_base) - jnp.log1p(-a_base)
    return {
        "x_prompt": nrm(ks[0], (BATCH, SEQ, D_MODEL), jnp.float32),
        "x_sample": nrm(ks[1], (DEC_BATCH, DEC_SEQ, D_MODEL), jnp.float32),
        "cache_k": nrm(ks[2], (L, DEC_BATCH, PAST_LEN, N_HEADS, HEAD_DIM), jnp.float32),
        "cache_v": nrm(ks[3], (L, DEC_BATCH, PAST_LEN, N_HEADS, HEAD_DIM), jnp.float32),
        "cache_logf": jax.nn.log_sigmoid(3.0 + nrm(ks[4], (L, DEC_BATCH, PAST_LEN, N_HEADS), jnp.float32)),
        "state_conv": nrm(ks[5], (L, DEC_BATCH, CONV_WIDTH - 1, D_RNN), jnp.float32),
        "state_h": 0.5 * nrm(ks[6], (L, DEC_BATCH, D_RNN), jnp.float32),
        "norm_mix": 1.0 + 0.05 * nrm(ks[7], (L, D_MODEL), jnp.float32),
        "w_in": nrm(ks[8], (L, D_MODEL, D_IN), jnp.float32) * D_MODEL ** -0.5,
        "b_forget": jax.random.uniform(ks[9], (L, N_HEADS), minval=1.0, maxval=5.0),
        "b_gate": 0.1 * nrm(ks[10], (L, 2 * D_MODEL), jnp.float32),
        "conv_w": 0.5 * nrm(ks[11], (L, CONV_WIDTH, D_RNN), jnp.float32),
        "conv_b": 0.05 * nrm(ks[12], (L, D_RNN), jnp.float32),
        "w_rg": nrm(ks[14], (L, N_LRU_BLOCKS, LRU_BLOCK, LRU_BLOCK), jnp.float32) * LRU_BLOCK ** -0.5,
        "b_rg": 0.05 * nrm(ks[15], (L, D_RNN), jnp.float32),
        "w_ig": nrm(ks[16], (L, N_LRU_BLOCKS, LRU_BLOCK, LRU_BLOCK), jnp.float32) * LRU_BLOCK ** -0.5,
        "b_ig": 0.05 * nrm(ks[17], (L, D_RNN), jnp.float32),
        "lru_lambda": lru_lambda,
        "w_br_lru": nrm(ks[18], (L, D_RNN, D_MODEL), jnp.float32) * D_RNN ** -0.5,
        "w_br_att": nrm(ks[19], (L, D_ATT, D_MODEL), jnp.float32) * D_ATT ** -0.5,
        "w_out": nrm(ks[20], (L, D_MODEL, D_MODEL), jnp.float32) * D_MODEL ** -0.5,
        "norm_ffn": 1.0 + 0.05 * nrm(ks[21], (L, D_MODEL), jnp.float32),
        "w_ffn_in": nrm(ks[22], (L, D_MODEL, 2 * D_FF), jnp.float32) * D_MODEL ** -0.5,
        "w_ffn_out": nrm(ks[23], (L, D_FF, D_MODEL), jnp.float32) * D_FF ** -0.5,
        "norm_final": 1.0 + 0.05 * nrm(ks[24], (D_MODEL,), jnp.float32),
    }


def reference(x_prompt, x_sample, cache_k, cache_v, cache_logf, state_conv, state_h,
              norm_mix, w_in, b_forget, b_gate, conv_w, conv_b, w_rg, b_rg, w_ig, b_ig, lru_lambda,
              w_br_lru, w_br_att, w_out, norm_ffn, w_ffn_in, w_ffn_out, norm_final):
    bp = x_prompt.shape[0]
    xp = x_prompt
    xs = x_sample
    kp_l, vp_l, lfp_l, cp_l, hp_l = [], [], [], [], []
    ks_l, vs_l, lfs_l, cs_l, hs_l = [], [], [], [], []
    for l in range(DEPTH):
        w = (norm_mix[l], w_in[l], b_forget[l], b_gate[l], conv_w[l], conv_b[l], w_rg[l], b_rg[l],
             w_ig[l], b_ig[l], lru_lambda[l], w_br_lru[l], w_br_att[l], w_out[l], norm_ffn[l],
             w_ffn_in[l], w_ffn_out[l])
        zero_buf = jnp.zeros((bp, CONV_WIDTH - 1, D_RNN), xp.dtype)
        zero_h = jnp.zeros((bp, D_RNN), xp.dtype)
        xp, kp, vp, lfp, cp, hp = layer(xp, zero_buf, zero_h, None, None, None, *w)
        xs, ksm, vsm, lfs, csm, hsm = layer(xs, state_conv[l], state_h[l], cache_k[l], cache_v[l], cache_logf[l], *w)
        kp_l.append(kp); vp_l.append(vp); lfp_l.append(lfp); cp_l.append(cp); hp_l.append(hp)
        ks_l.append(ksm); vs_l.append(vsm); lfs_l.append(lfs); cs_l.append(csm); hs_l.append(hsm)
    y_prompt = rmsnorm(xp, norm_final)
    y_sample = rmsnorm(xs, norm_final)
    return (y_prompt, y_sample,
            jnp.stack(kp_l), jnp.stack(vp_l), jnp.stack(lfp_l), jnp.stack(cp_l), jnp.stack(hp_l),
            jnp.stack(ks_l), jnp.stack(vs_l), jnp.stack(lfs_l), jnp.stack(cs_l), jnp.stack(hs_l))
```

```cpp
#include <hip/hip_runtime.h>
#include <hip/hip_cooperative_groups.h>
#include <cstdio>
#include <cstdint>
namespace cg = cooperative_groups;

#define LAS __attribute__((address_space(3)))
typedef unsigned short bf16_t;
typedef short bf16x8 __attribute__((ext_vector_type(8)));
typedef float f32x4 __attribute__((ext_vector_type(4)));
typedef float f32x2 __attribute__((ext_vector_type(2)));
typedef float f32x16 __attribute__((ext_vector_type(16)));
typedef unsigned u32x4 __attribute__((ext_vector_type(4)));
typedef unsigned u32x2 __attribute__((ext_vector_type(2)));
typedef short v4i16_t __attribute__((ext_vector_type(4)));

constexpr int MP = 16384, MS = 1024, M = MP + MS, D = 1024, NH = 16, HD = 64, DFF = 2816, DIN = 7184, NIN = 7168, PAST = 2048;
constexpr float EPS = 1e-6f, L2E = 1.4426950408889634f, QSCALE = 0.125f * 1.4426950408889634f;
constexpr size_t O_Y = 0, O_KP = (size_t)M * D, O_VP = O_KP + (size_t)MP * D, O_LFP = O_VP + (size_t)MP * D, O_CVP = O_LFP + (size_t)MP * NH,
                 O_HP = O_CVP + 3 * D, O_KS = O_HP + D, O_VS = O_KS + (size_t)MS * D, O_LFS = O_VS + (size_t)MS * D, O_CVS = O_LFS + (size_t)MS * NH,
                 O_HS = O_CVS + 16 * 3 * D, O_END = O_HS + 16 * D;
constexpr size_t MiB = 1u << 20;
constexpr size_t WS_CTL = 0, WS_RSS2 = 1 * MiB, WS_RSS3 = WS_RSS2 + 128 * 1024, WS_CSP = WS_RSS3 + 128 * 1024  , WS_CSC = WS_CSP + 32 * 1024  ,
                 WS_PFXP = WS_CSC + 64 * 1024  , WS_PFXC = WS_PFXP + 32 * 1024  , WS_PFXS = WS_PFXC + 64 * 1024  ,
                 WS_CLT = 2 * MiB  , WS_CLTC = 4 * MiB  ,
                 WS_WIN = 8 * MiB, WS_WCAT = 22 * MiB  , WS_WOUT = 26 * MiB, WS_WFFI = 28 * MiB, WS_WFFO = 39 * MiB,
                 WS_XN = 48 * MiB, WS_MIXED = 48 * MiB, WS_XR = 82 * MiB, WS_T1 = 82 * MiB, WS_GATE = 116 * MiB, WS_Q = 150 * MiB, WS_XG = 150 * MiB,
                 WS_K = 184 * MiB, WS_HFF = 184 * MiB, WS_V = 218 * MiB, WS_G = 252 * MiB, WS_YCAT = 320 * MiB  , WS_X2 = 388 * MiB, WS_HL = 388 * MiB, WS_PB = 422 * MiB, WS_END = 456 * MiB;
constexpr size_t WS_BAR = 16 * 1024;
constexpr size_t WS_N2 = WS_PFXS + 4096 + 128 * 1024  , WS_FLAG = WS_BAR + 15 * 1024  , WS_AGG = WS_PFXS + 4096  ;
constexpr int NSEG = 16, SEGLEN = MP / NSEG, SEGCH = SEGLEN / 64;
constexpr int LDS_BYTES = 147456;

struct Args { const float* in[25]; float* out; unsigned char* ws; int ph_lo, ph_hi; };

namespace pg8 {
constexpr int BM = 256, BK = 64, HALF = 128, HTB = HALF * BK * 2, STAGE_BYTES = 8 * HTB, NXCD = 8, WGM = 8;
__host__ __device__ __forceinline__ int lds_byte(int r, int c) { const int st = (r >> 4) * 2 + (c >> 5), rr = r & 15, cc = c & 31, ob = rr * 64 + cc * 2; return st * 1024 + (ob ^ (((ob >> 9) & 1) << 5)); }
__host__ __device__ __forceinline__ void stage_rc(int b, int& R, int& C) { const int st = b / 1024, sb = b % 1024, swz = sb ^ (((sb >> 9) & 1) << 5); R = (st >> 1) * 16 + swz / 64; C = (st & 1) * 32 + (swz % 64) / 2; }
__host__ __device__ __forceinline__ int perm32(int rho) { const int n = rho >> 4, i = rho & 15; return 8 * (i >> 2) + 4 * n + (i & 3); }
struct Unit { int pm, pn; };
struct Gemm { const bf16_t* A; const bf16_t* Bt; int M, N, K; };
struct StaticOrder {
    int nM, nN, nwg, G, c;
    __device__ void init(int M_, int N_, int G_, int c_) { nM = M_ / BM; nN = N_ / BM; nwg = nM * nN; G = G_; c = c_; }
    __device__ bool next(int i, Unit& u) const {
        const long L = (long)i * G + c; if (L >= nwg) return false;
        int wgid = (int)L; { const int q = nwg / NXCD, r = nwg % NXCD, xcd = wgid % NXCD, off = wgid / NXCD; wgid = (xcd < r ? xcd * (q + 1) : r * (q + 1) + (xcd - r) * q) + off; }
        const int nig = WGM * nN, gid = wgid / nig, fm = gid * WGM, gsz = (nM - fm) < WGM ? (nM - fm) : WGM;
        u.pm = fm + ((wgid % nig) % gsz); u.pn = (wgid % nig) / gsz; return true;
    }
};
__device__ __forceinline__ unsigned cvt_pk_bf16(float lo, float hi) { unsigned r; asm volatile("v_cvt_pk_bf16_f32 %0, %1, %2" : "=v"(r) : "v"(lo), "v"(hi)); return r; }

template <class Epi>
__device__ __forceinline__ void gemm_phase(LAS unsigned char* lds, const Gemm g, const StaticOrder& S, const Epi& E) {
    const int tid = threadIdx.x, wid = __builtin_amdgcn_readfirstlane(tid >> 6), lane = tid & 63, wr = wid >> 2, wc = wid & 3, fr = lane & 15, fq = lane >> 4;
    const int K = g.K, nt = K / BK;
    unsigned voffA[2], voffB[2];
#pragma unroll
    for (int i = 0; i < 2; ++i) { int R, C; stage_rc(tid * 16 + i * 8192, R, C); const int Rb = (R & ~31) + perm32(R & 31);
        voffA[i] = (unsigned)(R * K + C) * 2u; voffB[i] = (unsigned)(Rb * K + C) * 2u; }
    const size_t kstep = (size_t)(BK * 2);
    const size_t hstep = (size_t)HALF * K * 2;
    const size_t tstep = 2 * hstep;
    const unsigned ldsw = (unsigned)wid * 1024u;
    const int aoff = lds_byte(wr * 64 + fr, fq * 8), boff = lds_byte(wc * 32 + fr, fq * 8);
#define PG8_SA(b, h) (((b) * 2 + (h)) * HTB)
#define PG8_SB(b, h) ((4 + (b) * 2 + (h)) * HTB)
#define PG8_STAGE(bufoff, gbase, voff) do { _Pragma("unroll") for (int _i = 0; _i < 2; ++_i) \
        __builtin_amdgcn_global_load_lds((const unsigned*)((const char*)(gbase) + (voff)[_i]), (LAS unsigned*)(lds + (bufoff) + ldsw + _i * 8192), 16, 0, 0); } while (0)
#define PG8_LDA(dst, b, h) do { _Pragma("unroll") for (int m = 0; m < 4; ++m) _Pragma("unroll") for (int k = 0; k < 2; ++k) dst[m][k] = *(const LAS bf16x8*)(lds + PG8_SA(b, h) + aoff + m * 2048 + k * 1024); } while (0)
#define PG8_LDB(dst, b, h) do { _Pragma("unroll") for (int n = 0; n < 2; ++n) _Pragma("unroll") for (int k = 0; k < 2; ++k) dst[n][k] = *(const LAS bf16x8*)(lds + PG8_SB(b, h) + boff + n * 2048 + k * 1024); } while (0)
#define PG8_MMA(ai, bj, At, Bt) do { __builtin_amdgcn_s_setprio(1); _Pragma("unroll") for (int m = 0; m < 4; ++m) _Pragma("unroll") for (int n = 0; n < 2; ++n) _Pragma("unroll") for (int k = 0; k < 2; ++k) \
        acc[ai][bj][m][n] = __builtin_amdgcn_mfma_f32_16x16x32_bf16(Bt[n][k], At[m][k], acc[ai][bj][m][n], 0, 0, 0); __builtin_amdgcn_s_setprio(0); } while (0)
#define PG8_WAIT_V(n) asm volatile("s_waitcnt vmcnt(" #n ")" ::: "memory")
#define PG8_WAIT_L(n) asm volatile("s_waitcnt lgkmcnt(" #n ")" ::: "memory")
#define PG8_BAR __builtin_amdgcn_s_barrier()
#define PG8_SCHED __builtin_amdgcn_sched_barrier(0)
    Unit cur, nxt; int ui = 0;
    if (!S.next(0, cur)) return;
    f32x4 acc[2][2][4][2];
#pragma unroll
    for (int a = 0; a < 2; ++a)
#pragma unroll
        for (int b = 0; b < 2; ++b)
#pragma unroll
            for (int m = 0; m < 4; ++m)
#pragma unroll
                for (int n = 0; n < 2; ++n) acc[a][b][m][n] = (f32x4){0.f, 0.f, 0.f, 0.f};
    bf16x8 At[4][2], B0[2][2], B1[2][2];
    const char* cA = (const char*)g.A + (size_t)cur.pm * tstep; const char* cB = (const char*)g.Bt + (size_t)cur.pn * tstep;
    PG8_STAGE(PG8_SB(0, 0), cB, voffB); PG8_STAGE(PG8_SB(0, 1), cB + hstep, voffB); PG8_STAGE(PG8_SA(0, 0), cA, voffA); PG8_STAGE(PG8_SA(0, 1), cA + hstep, voffA);
    if (wr == 1) PG8_BAR;
    PG8_WAIT_V(2); PG8_BAR;
    PG8_STAGE(PG8_SB(1, 0), cB + kstep, voffB); PG8_STAGE(PG8_SA(1, 0), cA + kstep, voffA); PG8_STAGE(PG8_SB(1, 1), cB + hstep + kstep, voffB);
    PG8_WAIT_V(6); PG8_BAR;
    for (;;) {
        const bool has_next = S.next(ui + 1, nxt);
        const char* nA = has_next ? (const char*)g.A + (size_t)nxt.pm * tstep : cA; const char* nB = has_next ? (const char*)g.Bt + (size_t)nxt.pn * tstep : cB;
        for (int t = 0; t < nt; t += 2) {
            if constexpr (Epi::HAS_MID) { if (t == nt / 2) E.mid(acc, cur, wr, wc, fr, fq); }
            const bool last = (t == nt - 2);
            const char* a1 = cA + (size_t)(t + 1) * kstep;
            const char* a2 = last ? nA : cA + (size_t)(t + 2) * kstep; const char* b2 = last ? nB : cB + (size_t)(t + 2) * kstep;
            const char* a3 = a2 + kstep; const char* b3 = b2 + kstep;
            PG8_LDB(B0, 0, 0); PG8_LDB(B1, 0, 1); PG8_SCHED; PG8_LDA(At, 0, 0); PG8_STAGE(PG8_SA(1, 1), a1 + hstep, voffA);
            PG8_WAIT_V(8); PG8_WAIT_L(0); PG8_BAR; PG8_MMA(0, 0, At, B0); PG8_MMA(0, 1, At, B1); PG8_BAR; PG8_SCHED;
            PG8_LDA(At, 0, 1); PG8_STAGE(PG8_SB(0, 0), b2, voffB); PG8_STAGE(PG8_SB(0, 1), b2 + hstep, voffB); PG8_STAGE(PG8_SA(0, 0), a2, voffA);
            PG8_WAIT_V(8); PG8_WAIT_L(0); PG8_BAR; PG8_MMA(1, 0, At, B0); PG8_MMA(1, 1, At, B1); PG8_BAR; PG8_SCHED;
            PG8_LDB(B0, 1, 0); PG8_LDB(B1, 1, 1); PG8_SCHED; PG8_LDA(At, 1, 0); PG8_STAGE(PG8_SA(0, 1), a2 + hstep, voffA);
            PG8_WAIT_V(8); PG8_WAIT_L(0); PG8_BAR; PG8_MMA(0, 0, At, B0); PG8_MMA(0, 1, At, B1); PG8_BAR; PG8_SCHED;
            PG8_LDA(At, 1, 1); PG8_STAGE(PG8_SB(1, 0), b3, voffB); PG8_STAGE(PG8_SB(1, 1), b3 + hstep, voffB); PG8_STAGE(PG8_SA(1, 0), a3, voffA);
            PG8_WAIT_V(8); PG8_WAIT_L(0); PG8_BAR; PG8_MMA(1, 0, At, B0); PG8_MMA(1, 1, At, B1); PG8_BAR; PG8_SCHED;
        }
        if (wr == 0) PG8_BAR;
        E(acc, cur, wr, wc, fr, fq);
        if (!has_next) break;
#pragma unroll
        for (int a = 0; a < 2; ++a)
#pragma unroll
            for (int b = 0; b < 2; ++b)
#pragma unroll
                for (int m = 0; m < 4; ++m)
#pragma unroll
                    for (int n = 0; n < 2; ++n) acc[a][b][m][n] = (f32x4){0.f, 0.f, 0.f, 0.f};
        cur = nxt; cA = nA; cB = nB; ++ui;
        if (wr == 1) PG8_BAR;
    }
    PG8_WAIT_V(0);
    PG8_BAR;
#undef PG8_SA
#undef PG8_SB
#undef PG8_STAGE
#undef PG8_LDA
#undef PG8_LDB
#undef PG8_MMA
#undef PG8_WAIT_V
#undef PG8_WAIT_L
#undef PG8_BAR
#undef PG8_SCHED
}
}
using pg8::cvt_pk_bf16;

__device__ __forceinline__ float fast_sigmoid(float z) { return __builtin_amdgcn_rcpf(1.f + __builtin_amdgcn_exp2f(-z * L2E)); }
__device__ __forceinline__ float gelu_tanh(float x) { const float u = 0.7978845608028654f * (x + 0.044715f * x * x * x); return x * fast_sigmoid(2.f * u); }
__device__ __forceinline__ u32x4 pack8(f32x4 a, f32x4 b) { u32x4 w; w.x = cvt_pk_bf16(a[0], a[1]); w.y = cvt_pk_bf16(a[2], a[3]); w.z = cvt_pk_bf16(b[0], b[1]); w.w = cvt_pk_bf16(b[2], b[3]); return w; }
__device__ __forceinline__ float wave_sum(float v) {
#pragma unroll
    for (int o = 1; o < 64; o <<= 1) v += __shfl_xor(v, o);
    return v;
}
#define EPI_LOOP(...) _Pragma("unroll") for (int ai = 0; ai < 2; ++ai) _Pragma("unroll") for (int m = 0; m < 4; ++m) { const int row = u.pm * 256 + ai * 128 + wr * 64 + m * 16 + fr; \
    _Pragma("unroll") for (int bj = 0; bj < 2; ++bj) { const int tc = bj * 128 + wc * 32 + 8 * fq; f32x4 v0 = acc[ai][bj][m][0], v1 = acc[ai][bj][m][1]; __VA_ARGS__ } }

__device__ __forceinline__ void unpack_bf16x8(const u32x4 g, f32x4& g0, f32x4& g1) {
    g0[0] = __uint_as_float(g.x << 16); g0[1] = __uint_as_float(g.x & 0xffff0000u); g0[2] = __uint_as_float(g.y << 16); g0[3] = __uint_as_float(g.y & 0xffff0000u);
    g1[0] = __uint_as_float(g.z << 16); g1[1] = __uint_as_float(g.z & 0xffff0000u); g1[2] = __uint_as_float(g.w << 16); g1[3] = __uint_as_float(g.w & 0xffff0000u);
}
struct EpiIn {
    static constexpr bool PERM = true, HAS_MID = false;
    bf16_t *XR, *GATE, *Q, *K, *V, *G; float* out; const float* b_gate;
    __device__ __forceinline__ void operator()(const f32x4 (&acc)[2][2][4][2], const pg8::Unit& u, int wr, int wc, int fr, int fq) const {
        const int seg = u.pn >> 2, ct = (u.pn & 3) * 256;
        if (seg == 0) {
            EPI_LOOP({ const int col = ct + tc; *(u32x4*)(XR + (size_t)row * D + col) = pack8(v0, v1);
                       const int rr = row < MP ? row - (MP - 3) : ((row & 63) - 61);
                       if (rr >= 0) { float* o = row < MP ? out + O_CVP + (size_t)rr * D + col : out + O_CVS + ((size_t)((row - MP) >> 6) * 3 + rr) * D + col; *(f32x4*)o = v0; *(f32x4*)(o + 4) = v1; } })
        } else if (seg == 1) {
            EPI_LOOP({ const int col = ct + tc; _Pragma("unroll") for (int i = 0; i < 4; ++i) { v0[i] = gelu_tanh(v0[i]); v1[i] = gelu_tanh(v1[i]); }
                       *(u32x4*)(GATE + (size_t)row * D + col) = pack8(v0, v1); })
        } else if (seg == 2) {
            EPI_LOOP({ const int col = ct + tc; *(u32x4*)(Q + (size_t)row * D + col) = pack8(v0 * QSCALE, v1 * QSCALE); })
        } else if (seg == 3 || seg == 4) {
            bf16_t* B = seg == 3 ? K : V; const size_t op = seg == 3 ? O_KP : O_VP, os = seg == 3 ? O_KS : O_VS;
            EPI_LOOP({ const int col = ct + tc; *(u32x4*)(B + (size_t)row * D + col) = pack8(v0, v1);
                       float* o = row < MP ? out + op + (size_t)row * D + col : out + os + (size_t)(row - MP) * D + col; *(f32x4*)o = v0; *(f32x4*)(o + 4) = v1; })
        } else {
            const int gt = (u.pn - 20) * 256;
            EPI_LOOP({ const int col = gt + tc; const f32x4 b0 = *(const f32x4*)(b_gate + col), b1 = *(const f32x4*)(b_gate + col + 4);
                       _Pragma("unroll") for (int i = 0; i < 4; ++i) { v0[i] = fast_sigmoid(v0[i] + b0[i]); v1[i] = fast_sigmoid(v1[i] + b1[i]); }
                       *(u32x4*)(G + (size_t)row * 2048 + col) = pack8(v0, v1); })
        }
    }
};
struct EpiM1 {
    static constexpr bool PERM = true, HAS_MID = false;
    const bf16_t* G; float* T1;
    __device__ __forceinline__ void operator()(const f32x4 (&acc)[2][2][4][2], const pg8::Unit& u, int wr, int wc, int fr, int fq) const {
        EPI_LOOP({ const int col = u.pn * 256 + tc; const u32x4 g = *(const u32x4*)(G + (size_t)row * 2048 + col);
                   f32x4 g0, g1; g0[0] = __uint_as_float(g.x << 16); g0[1] = __uint_as_float(g.x & 0xffff0000u); g0[2] = __uint_as_float(g.y << 16); g0[3] = __uint_as_float(g.y & 0xffff0000u);
                   g1[0] = __uint_as_float(g.z << 16); g1[1] = __uint_as_float(g.z & 0xffff0000u); g1[2] = __uint_as_float(g.w << 16); g1[3] = __uint_as_float(g.w & 0xffff0000u);
                   float* o = T1 + (size_t)row * D + col; *(f32x4*)o = v0 * g0; *(f32x4*)(o + 4) = v1 * g1; })
    }
};
struct EpiM2 {
    static constexpr bool PERM = true, HAS_MID = false;
    const bf16_t* G; const float* T1; bf16_t* MIXED;
    __device__ __forceinline__ void operator()(const f32x4 (&acc)[2][2][4][2], const pg8::Unit& u, int wr, int wc, int fr, int fq) const {
        EPI_LOOP({ const int col = u.pn * 256 + tc; const u32x4 g = *(const u32x4*)(G + (size_t)row * 2048 + 1024 + col);
                   f32x4 g0, g1; g0[0] = __uint_as_float(g.x << 16); g0[1] = __uint_as_float(g.x & 0xffff0000u); g0[2] = __uint_as_float(g.y << 16); g0[3] = __uint_as_float(g.y & 0xffff0000u);
                   g1[0] = __uint_as_float(g.z << 16); g1[1] = __uint_as_float(g.z & 0xffff0000u); g1[2] = __uint_as_float(g.w << 16); g1[3] = __uint_as_float(g.w & 0xffff0000u);
                   const float* t = T1 + (size_t)row * D + col; const f32x4 t0 = *(const f32x4*)t, t1 = *(const f32x4*)(t + 4);
                   *(u32x4*)(MIXED + (size_t)row * D + col) = pack8(t0 + v0 * g0, t1 + v1 * g1); })
    }
};
struct EpiMerge {
    static constexpr bool PERM = true, HAS_MID = true;
    const bf16_t* G; bf16_t* MIXED;
    __device__ __forceinline__ void mid(f32x4 (&acc)[2][2][4][2], const pg8::Unit& u, int wr, int wc, int fr, int fq) const {
#pragma unroll
        for (int ai = 0; ai < 2; ++ai)
#pragma unroll
            for (int m = 0; m < 4; ++m) { const int row = u.pm * 256 + ai * 128 + wr * 64 + m * 16 + fr;
#pragma unroll
                for (int bj = 0; bj < 2; ++bj) { const int col = u.pn * 256 + bj * 128 + wc * 32 + 8 * fq; const bf16_t* gp = G + (size_t)row * 2048 + col;
                    f32x4 l0, l1, a0, a1; unpack_bf16x8(*(const u32x4*)gp, l0, l1); unpack_bf16x8(*(const u32x4*)(gp + 1024), a0, a1);
#pragma unroll
                    for (int i = 0; i < 4; ++i) { acc[ai][bj][m][0][i] *= l0[i] * __builtin_amdgcn_rcpf(fmaxf(a0[i], 1e-30f)); acc[ai][bj][m][1][i] *= l1[i] * __builtin_amdgcn_rcpf(fmaxf(a1[i], 1e-30f)); } } }
    }
    __device__ __forceinline__ void operator()(const f32x4 (&acc)[2][2][4][2], const pg8::Unit& u, int wr, int wc, int fr, int fq) const {
        EPI_LOOP({ const int col = u.pn * 256 + tc; f32x4 a0, a1; unpack_bf16x8(*(const u32x4*)(G + (size_t)row * 2048 + 1024 + col), a0, a1);
                   _Pragma("unroll") for (int i = 0; i < 4; ++i) { a0[i] = fmaxf(a0[i], 1e-30f); a1[i] = fmaxf(a1[i], 1e-30f); }
                   *(u32x4*)(MIXED + (size_t)row * D + col) = pack8(v0 * a0, v1 * a1); })
    }
};
struct EpiOut {
    static constexpr bool PERM = true, HAS_MID = false;
    const float *xp, *xs; bf16_t* X2B; float* rss;
    __device__ __forceinline__ void operator()(const f32x4 (&acc)[2][2][4][2], const pg8::Unit& u, int wr, int wc, int fr, int fq) const {
#pragma unroll
        for (int ai = 0; ai < 2; ++ai)
#pragma unroll
            for (int m = 0; m < 4; ++m) { const int row = u.pm * 256 + ai * 128 + wr * 64 + m * 16 + fr; float ss = 0.f;
                const float* xrow = row < MP ? xp + (size_t)row * D : xs + (size_t)(row - MP) * D;
#pragma unroll
                for (int bj = 0; bj < 2; ++bj) { const int col = u.pn * 256 + bj * 128 + wc * 32 + 8 * fq;
                    f32x4 v0 = acc[ai][bj][m][0] + *(const f32x4*)(xrow + col), v1 = acc[ai][bj][m][1] + *(const f32x4*)(xrow + col + 4);
                    ss += (v0[0] * v0[0] + v0[1] * v0[1]) + (v0[2] * v0[2] + v0[3] * v0[3]) + (v1[0] * v1[0] + v1[1] * v1[1]) + (v1[2] * v1[2] + v1[3] * v1[3]);
                    *(u32x4*)(X2B + (size_t)row * D + col) = pack8(v0, v1); }
                ss += __shfl_xor(ss, 16); ss += __shfl_xor(ss, 32);
                if (fq == 0) atomicAdd(rss + row, ss); }
    }
};
struct EpiFfnIn {
    static constexpr bool PERM = true, HAS_MID = false;
    const float* rss; bf16_t* HFF;
    __device__ __forceinline__ void operator()(const f32x4 (&acc)[2][2][4][2], const pg8::Unit& u, int wr, int wc, int fr, int fq) const {
#pragma unroll
        for (int ai = 0; ai < 2; ++ai)
#pragma unroll
            for (int m = 0; m < 4; ++m) { const int row = u.pm * 256 + ai * 128 + wr * 64 + m * 16 + fr;
                const float rstd = __builtin_amdgcn_rsqf(rss[row] * (1.f / D) + EPS);
                f32x4 h0, h1;
#pragma unroll
                for (int i = 0; i < 4; ++i) { const float g0 = acc[ai][0][m][0][i] * rstd, u0 = acc[ai][1][m][0][i] * rstd, g1 = acc[ai][0][m][1][i] * rstd, u1 = acc[ai][1][m][1][i] * rstd;
                    h0[i] = g0 * fast_sigmoid(g0) * u0; h1[i] = g1 * fast_sigmoid(g1) * u1; }
                *(u32x4*)(HFF + (size_t)row * DFF + u.pn * 128 + wc * 32 + 8 * fq) = pack8(h0, h1); }
    }
};
struct EpiFfnOut {
    static constexpr bool PERM = true, HAS_MID = false;
    const bf16_t* X2B; bf16_t* X3B; float* rss;
    __device__ __forceinline__ void operator()(const f32x4 (&acc)[2][2][4][2], const pg8::Unit& u, int wr, int wc, int fr, int fq) const {
#pragma unroll
        for (int ai = 0; ai < 2; ++ai)
#pragma unroll
            for (int m = 0; m < 4; ++m) { const int row = u.pm * 256 + ai * 128 + wr * 64 + m * 16 + fr; float ss = 0.f;
#pragma unroll
                for (int bj = 0; bj < 2; ++bj) { const int col = u.pn * 256 + bj * 128 + wc * 32 + 8 * fq;
                    f32x4 x0, x1; unpack_bf16x8(*(const u32x4*)(X2B + (size_t)row * D + col), x0, x1);
                    const f32x4 v0 = acc[ai][bj][m][0] + x0, v1 = acc[ai][bj][m][1] + x1;
                    ss += (v0[0] * v0[0] + v0[1] * v0[1]) + (v0[2] * v0[2] + v0[3] * v0[3]) + (v1[0] * v1[0] + v1[1] * v1[1]) + (v1[2] * v1[2] + v1[3] * v1[3]);
                    *(u32x4*)(X3B + (size_t)row * D + col) = pack8(v0, v1); }
                ss += __shfl_xor(ss, 16); ss += __shfl_xor(ss, 32);
                if (fq == 0) atomicAdd(rss + row, ss); }
    }
};

__device__ __forceinline__ void p0_transpose_item(const float* W, int ldw, int k0, int n0, bf16_t* WT, int ldt, int dst_row0, LAS float* scr, int lane, const float* kscale = nullptr) {
#pragma unroll
    for (int i = 0; i < 32; ++i) { const int kk = 2 * i + (lane >> 5); scr[kk * 33 + (lane & 31)] = W[(size_t)(k0 + kk) * ldw + n0 + (lane & 31)] * (kscale ? kscale[k0 + kk] : 1.f); }
    asm volatile("s_waitcnt lgkmcnt(0)" ::: "memory");
    const int c = lane & 7;
#pragma unroll
    for (int j = 0; j < 4; ++j) { const int n = (lane >> 3) + 8 * j; const LAS float* s = scr + (8 * c) * 33 + n;
        u32x4 o; o.x = cvt_pk_bf16(s[0 * 33], s[1 * 33]); o.y = cvt_pk_bf16(s[2 * 33], s[3 * 33]); o.z = cvt_pk_bf16(s[4 * 33], s[5 * 33]); o.w = cvt_pk_bf16(s[6 * 33], s[7 * 33]);
        *(u32x4*)(WT + (size_t)(dst_row0 + n) * ldt + k0 + 8 * c) = o; }
    asm volatile("s_waitcnt lgkmcnt(0)" ::: "memory");
}
constexpr int P0_SCR = 0  , P0_WFL = 69632  , P0_LF = P0_WFL + 65536  , P0_SEG = P0_LF + 4096  ;
__device__ __forceinline__ void p0_phase(const Args& a, LAS unsigned char* lds, int tid, int lane, int wave) {
    unsigned char* ws = a.ws;
    { float* r2 = (float*)(ws + WS_RSS2); float* r3 = (float*)(ws + WS_RSS3);
      for (int i = blockIdx.x * 512 + tid; i < M; i += gridDim.x * 512) { r2[i] = 0.f; r3[i] = 0.f; }
      if (blockIdx.x == 0 && tid == 0) ((unsigned*)(ws + WS_CTL))[0] = 0u; }
    LAS float* wfl = (LAS float*)(lds + P0_WFL);
    { const float* w_in = a.in[8];
      for (int i = tid; i < 4096; i += 512) { const int col = i >> 2, q = i & 3; *(LAS f32x4*)(wfl + col * 16 + 4 * q) = *(const f32x4*)(w_in + (size_t)col * DIN + NIN + 4 * q); } }
    __syncthreads();
    LAS float* lf = (LAS float*)(lds + P0_LF);
    LAS float* sg = (LAS float*)(lds + P0_SEG);
    const float* gmix = a.in[7]; const float* bfg = a.in[9];
    float gm[16];
#pragma unroll
    for (int j = 0; j < 16; ++j) gm[j] = gmix[lane + 64 * j];
    bf16_t* XN = (bf16_t*)(ws + WS_XN);
    for (int c = blockIdx.x; c < 784; c += gridDim.x) {
        if (c < 272) {
            for (int i4 = 0; i4 < 2; ++i4) {
                float xa[4][16];
#pragma unroll
                for (int u = 0; u < 4; ++u) { const int row = c * 64 + wave * 8 + i4 * 4 + u; const float* xrow = row < MP ? a.in[0] + (size_t)row * D : a.in[1] + (size_t)(row - MP) * D;
#pragma unroll
                    for (int j = 0; j < 16; ++j) xa[u][j] = xrow[lane + 64 * j]; }
#pragma unroll
                for (int u = 0; u < 4; ++u) {
                const int rl = wave * 8 + i4 * 4 + u, row = c * 64 + rl;
                float ss = 0.f;
#pragma unroll
                for (int j = 0; j < 16; ++j) ss += xa[u][j] * xa[u][j];
                const float rstd = 1.0f / sqrtf(wave_sum(ss) * (1.f / D) + EPS);
                float f[16];
#pragma unroll
                for (int h = 0; h < 16; ++h) f[h] = 0.f;
#pragma unroll
                for (int j = 0; j < 16; ++j) { const float xn = xa[u][j] * rstd * gm[j];
                    XN[(size_t)row * D + lane + 64 * j] = (bf16_t)(cvt_pk_bf16(xn, 0.f) & 0xffffu);
                    const LAS f32x4* wp = (const LAS f32x4*)(wfl + (lane + 64 * j) * 16);
#pragma unroll
                    for (int q = 0; q < 4; ++q) { const f32x4 w = wp[q]; f[4 * q + 0] += xn * w[0]; f[4 * q + 1] += xn * w[1]; f[4 * q + 2] += xn * w[2]; f[4 * q + 3] += xn * w[3]; } }
                { const bool b5 = lane & 32;
#pragma unroll
                  for (int k = 0; k < 8; ++k) { const float send = b5 ? f[k] : f[k + 8], keep = b5 ? f[k + 8] : f[k]; f[k] = keep + __shfl_xor(send, 32); }
                  const bool b4 = lane & 16;
#pragma unroll
                  for (int k = 0; k < 4; ++k) { const float send = b4 ? f[k] : f[k + 4], keep = b4 ? f[k + 4] : f[k]; f[k] = keep + __shfl_xor(send, 16); }
                  const bool b3 = lane & 8;
#pragma unroll
                  for (int k = 0; k < 2; ++k) { const float send = b3 ? f[k] : f[k + 2], keep = b3 ? f[k + 2] : f[k]; f[k] = keep + __shfl_xor(send, 8); }
                  const bool b2 = lane & 4;
                  { const float send = b2 ? f[0] : f[1], keep = b2 ? f[1] : f[0]; f[0] = keep + __shfl_xor(send, 4); }
                  f[0] += __shfl_xor(f[0], 2); f[0] += __shfl_xor(f[0], 1); }
                if ((lane & 3) == 0) { const int hh = ((lane >> 5) & 1) * 8 + ((lane >> 4) & 1) * 4 + ((lane >> 3) & 1) * 2 + ((lane >> 2) & 1);
                    const float z = f[0] + bfg[hh]; const float lg = fminf(z, 0.f) - log1pf(expf(-fabsf(z)));
                    lf[rl * 16 + hh] = lg;
                    if (row < MP) a.out[O_LFP + (size_t)row * NH + hh] = lg; else a.out[O_LFS + (size_t)(row - MP) * NH + hh] = lg; }
                }
            }
        } else {
            const int cc = c - 272; const float* src = a.in[4] + (size_t)cc * 1024;
            lf[tid] = src[tid]; lf[tid + 512] = src[tid + 512];
        }
        __syncthreads();
        float s0 = 0.f, s1 = 0.f, s2 = 0.f, s3 = 0.f; const int hh = tid & 15, seg = tid >> 4;
        if (tid < 256) { s0 = lf[(seg * 4 + 0) * 16 + hh]; s1 = s0 + lf[(seg * 4 + 1) * 16 + hh]; s2 = s1 + lf[(seg * 4 + 2) * 16 + hh]; s3 = s2 + lf[(seg * 4 + 3) * 16 + hh]; sg[seg * 16 + hh] = s3; }
        __syncthreads();
        if (tid < 256) { float pre = 0.f;
#pragma unroll
            for (int s = 0; s < 16; ++s) { const float v = sg[s * 16 + hh]; pre += (s < seg) ? v : 0.f; }
            float* dst;
            if (c < 272) dst = (float*)(ws + WS_CLT) + (size_t)hh * M + c * 64 + seg * 4;
            else { const int cc = c - 272; dst = (float*)(ws + WS_CLTC) + ((size_t)((cc >> 5) * 16 + hh) * PAST) + (cc & 31) * 64 + seg * 4; }
            *(f32x4*)dst = (f32x4){pre + s0, pre + s1, pre + s2, pre + s3};
            if (seg == 15) { if (c < 272) ((float*)(ws + WS_CSP))[c * 16 + hh] = pre + s3; else ((float*)(ws + WS_CSC))[(c - 272) * 16 + hh] = pre + s3; } }
        __syncthreads();
    }
    LAS float* scr = (LAS float*)(lds + P0_SCR + wave * 8448);
    const int gw = gridDim.x > 32 ? ((int)blockIdx.x - 16) * 8 + wave : (int)blockIdx.x * 8 + wave, NGW = gridDim.x > 32 ? (gridDim.x - 16) * 8 : gridDim.x * 8;
    constexpr int I_IN = 16 * (NIN / 32), I_SQ = 16 * 32, I_FFI = 16 * (2 * DFF / 32), I_FFO = (DFF / 64) * 32;
    constexpr int NITEMS = I_IN + 3 * I_SQ + I_FFI + I_FFO;
    for (int it = gw < 0 ? NITEMS : gw; it < NITEMS; it += NGW) {
        int r = it;
        if (r < I_IN) { const int nb = NIN / 32, kb = r / nb, n0 = (r % nb) * 32; p0_transpose_item(a.in[8], DIN, kb * 64, n0, (bf16_t*)(ws + WS_WIN), D, n0, scr, lane); continue; } r -= I_IN;
        if (r < I_SQ) { const int kb = r / 32, n0 = (r % 32) * 32; p0_transpose_item(a.in[18], D, kb * 64, n0, (bf16_t*)(ws + WS_WCAT), 2 * D, n0, scr, lane); continue; } r -= I_SQ;
        if (r < I_SQ) { const int kb = r / 32, n0 = (r % 32) * 32; p0_transpose_item(a.in[19], D, kb * 64, n0, (bf16_t*)(ws + WS_WCAT) + D, 2 * D, n0, scr, lane); continue; } r -= I_SQ;
        if (r < I_SQ) { const int kb = r / 32, n0 = (r % 32) * 32; p0_transpose_item(a.in[20], D, kb * 64, n0, (bf16_t*)(ws + WS_WOUT), D, n0, scr, lane); continue; } r -= I_SQ;
        if (r < I_FFI) { const int nb = 2 * DFF / 32, kb = r / nb, n0 = (r % nb) * 32; const int nn = n0 < DFF ? n0 : n0 - DFF; const int drow = (nn >> 7) * 256 + (n0 < DFF ? 0 : 128) + (nn & 127);
            p0_transpose_item(a.in[22], 2 * DFF, kb * 64, n0, (bf16_t*)(ws + WS_WFFI), D, drow, scr, lane, a.in[21]); continue; } r -= I_FFI;
        { const int kb = r / 32, n0 = (r % 32) * 32; p0_transpose_item(a.in[23], D, kb * 64, n0, (bf16_t*)(ws + WS_WFFO), DFF, n0, scr, lane); }
    }
}

__device__ __forceinline__ void prefix_task(const Args& a, LAS unsigned char* lds, int tid) {
    unsigned char* ws = a.ws;
    LAS float* sp = (LAS float*)lds;
    LAS float* sc = (LAS float*)(lds + 32768);
    const float* csp = (const float*)(ws + WS_CSP); const float* csc = (const float*)(ws + WS_CSC);
    for (int i = tid; i < 272 * 16; i += 512) sp[i] = csp[i];
    for (int i = tid; i < 512 * 16; i += 512) sc[i] = csc[i];
    __syncthreads();
    if (tid < 16) { float run = 0.f; float* o = (float*)(ws + WS_PFXP) + tid * 256;
        for (int c = 0; c < 256; ++c) { o[c] = run; run += sp[c * 16 + tid]; } }
    else if (tid >= 64 && tid < 64 + 256) { const int bh = tid - 64, b = bh >> 4, h = bh & 15; float run = 0.f; float* o = (float*)(ws + WS_PFXC) + bh * 32;
        for (int c = 0; c < 32; ++c) { o[c] = run; run += sc[(b * 32 + c) * 16 + h]; }
        ((float*)(ws + WS_PFXS))[bh] = run; }
    __syncthreads();
}

constexpr int AT_K = 0, AT_KB = 64 * 144, AT_V = 2 * AT_KB, AT_VB = 64 * 160, AT_CK = AT_V + 2 * AT_VB, AT_END = AT_CK + 512;
__device__ __forceinline__ int crow(int r, int hi) { return (r & 3) + 8 * (r >> 2) + 4 * hi; }
__device__ __forceinline__ void attn_tile(const LAS unsigned char* Kt, const LAS unsigned char* Vt, const LAS f32x4* ck, const bf16x8 (&qr)[4], const float cq2, const int kp0, const int qpos, const int qfirst,
                                          const int lane, const int r32, const int hi, float& m_run, float& l_run, float& cqm, f32x16& o0, f32x16& o1) {
            f32x16 p0, p1;
            const bool first = (m_run == -INFINITY);
            const float cbase = first ? cq2 : cqm;
#pragma unroll
            for (int g = 0; g < 4; ++g) { const f32x4 c0 = ck[2 * g + hi], c1 = ck[8 + 2 * g + hi];
#pragma unroll
                for (int i = 0; i < 4; ++i) { p0[4 * g + i] = cbase - c0[i]; p1[4 * g + i] = cbase - c1[i]; } }
#pragma unroll
            for (int d0 = 0; d0 < 4; ++d0) {
                const bf16x8 k0 = *(const LAS bf16x8*)(Kt + r32 * 144 + d0 * 32 + hi * 16), k1 = *(const LAS bf16x8*)(Kt + (32 + r32) * 144 + d0 * 32 + hi * 16);
                p0 = __builtin_amdgcn_mfma_f32_32x32x16_bf16(k0, qr[d0], p0, 0, 0, 0); p1 = __builtin_amdgcn_mfma_f32_32x32x16_bf16(k1, qr[d0], p1, 0, 0, 0); }
            if (kp0 + 63 > qfirst) {
#pragma unroll
                for (int r = 0; r < 16; ++r) { const int kk = kp0 + crow(r, hi); if (kk > qpos) p0[r] = -INFINITY; if (kk + 32 > qpos) p1[r] = -INFINITY; } }
            float rm = fmaxf(p0[0], p1[0]);
#pragma unroll
            for (int r = 1; r < 16; ++r) rm = fmaxf(rm, fmaxf(p0[r], p1[r]));
            rm = fmaxf(rm, __shfl_xor(rm, 32));
            if (first) { m_run = rm; cqm = cq2 - rm;
#pragma unroll
                for (int r = 0; r < 16; ++r) { p0[r] -= rm; p1[r] -= rm; } }
            else if (__any(rm > 8.f)) { const float dl = fmaxf(rm, 0.f), alpha = __builtin_amdgcn_exp2f(-dl); m_run += dl; cqm -= dl; l_run *= alpha;
#pragma unroll
                for (int r = 0; r < 16; ++r) { p0[r] -= dl; p1[r] -= dl; o0[r] *= alpha; o1[r] *= alpha; } }
            float ps = 0.f;
#pragma unroll
            for (int r = 0; r < 16; ++r) { p0[r] = __builtin_amdgcn_exp2f(p0[r]); p1[r] = __builtin_amdgcn_exp2f(p1[r]); ps += p0[r] + p1[r]; }
            l_run += ps;
            bf16x8 pa[4];
            { u32x4 w;
              w.x = cvt_pk_bf16(p0[0], p0[1]); w.y = cvt_pk_bf16(p0[2], p0[3]); w.z = cvt_pk_bf16(p0[4], p0[5]); w.w = cvt_pk_bf16(p0[6], p0[7]); pa[0] = __builtin_bit_cast(bf16x8, w);
              w.x = cvt_pk_bf16(p0[8], p0[9]); w.y = cvt_pk_bf16(p0[10], p0[11]); w.z = cvt_pk_bf16(p0[12], p0[13]); w.w = cvt_pk_bf16(p0[14], p0[15]); pa[1] = __builtin_bit_cast(bf16x8, w);
              w.x = cvt_pk_bf16(p1[0], p1[1]); w.y = cvt_pk_bf16(p1[2], p1[3]); w.z = cvt_pk_bf16(p1[4], p1[5]); w.w = cvt_pk_bf16(p1[6], p1[7]); pa[2] = __builtin_bit_cast(bf16x8, w);
              w.x = cvt_pk_bf16(p1[8], p1[9]); w.y = cvt_pk_bf16(p1[10], p1[11]); w.z = cvt_pk_bf16(p1[12], p1[13]); w.w = cvt_pk_bf16(p1[14], p1[15]); pa[3] = __builtin_bit_cast(bf16x8, w); }
            const LAS unsigned char* vbase = Vt + (4 * hi + ((lane & 15) >> 2)) * 160 + ((lane >> 4) & 1) * 32 + (lane & 3) * 8;
#pragma unroll
            for (int kk = 0; kk < 4; ++kk) {
#pragma unroll
                for (int dh = 0; dh < 2; ++dh) {
                    const v4i16_t lo = __builtin_amdgcn_ds_read_tr16_b64_v4i16((LAS v4i16_t*)(vbase + kk * 16 * 160 + dh * 64));
                    const v4i16_t hv = __builtin_amdgcn_ds_read_tr16_b64_v4i16((LAS v4i16_t*)(vbase + kk * 16 * 160 + 8 * 160 + dh * 64));
                    const bf16x8 vf = (bf16x8){lo[0], lo[1], lo[2], lo[3], hv[0], hv[1], hv[2], hv[3]};
                    if (dh == 0) o0 = __builtin_amdgcn_mfma_f32_32x32x16_bf16(vf, pa[kk], o0, 0, 0, 0); else o1 = __builtin_amdgcn_mfma_f32_32x32x16_bf16(vf, pa[kk], o1, 0, 0, 0); } }
}

__device__ __forceinline__ void attn_unit(const Args& a, LAS unsigned char* lds, const int mode, const int h, const int qb, const int tid_in, const int lane_in, const int wave) {
    int tid = tid_in; asm volatile("" : "+v"(tid)); const int lane = tid & 63;
    unsigned char* ws = a.ws;
    const bf16_t* Qb = (const bf16_t*)(ws + WS_Q); const bf16_t* Kb = (const bf16_t*)(ws + WS_K); const bf16_t* Vb = (const bf16_t*)(ws + WS_V);
    const float* CLT = (const float*)(ws + WS_CLT) + (size_t)h * M;
    const int r32 = lane & 31, hi = lane >> 5;
    const int NT = mode == 0 ? 4 * qb + 4 : 33;
    const int nqw = mode == 0 ? 8 : 2;
    const bool active = wave < nqw;
    const int qrow = mode == 0 ? qb * 256 + wave * 32 + r32 : MP + qb * 64 + (wave & 1) * 32 + r32;
    const int qpos = mode == 0 ? qrow : PAST + (wave & 1) * 32 + r32;
    const int qfirst = qpos - r32;
    float cq2; bf16x8 qr[4];
    { const float pfx = mode == 0 ? ((const float*)(ws + WS_PFXP))[h * 256 + (qrow >> 6)] : ((const float*)(ws + WS_PFXS))[qb * 16 + h];
      cq2 = (pfx + CLT[qrow]) * L2E;
#pragma unroll
      for (int d0 = 0; d0 < 4; ++d0) qr[d0] = *(const bf16x8*)(Qb + (size_t)qrow * D + h * HD + d0 * 16 + hi * 8); }
    const int sr = tid >> 3, sc8 = tid & 7;
    f32x4 kst[2], vst[2]; float ckst = 0.f;
    auto tile_load = [&](int j) {
        if (mode == 1 && j < 32) {
            const size_t off = (((size_t)(qb * PAST + j * 64 + sr)) * NH + h) * HD + sc8 * 8;
            const float* kp = a.in[2] + off; const float* vp = a.in[3] + off;
            kst[0] = *(const f32x4*)kp; kst[1] = *(const f32x4*)(kp + 4); vst[0] = *(const f32x4*)vp; vst[1] = *(const f32x4*)(vp + 4);
            if (tid < 64) ckst = (((const float*)(ws + WS_PFXC))[(qb * 16 + h) * 32 + j] + ((const float*)(ws + WS_CLTC))[(size_t)(qb * 16 + h) * PAST + j * 64 + tid]) * L2E;
        } else {
            const int krow = mode == 0 ? j * 64 : MP + qb * 64;
            const size_t off = (size_t)(krow + sr) * D + h * HD + sc8 * 8;
            kst[0] = *(const f32x4*)(Kb + off); vst[0] = *(const f32x4*)(Vb + off);
            if (tid < 64) { const float pfx = mode == 0 ? ((const float*)(ws + WS_PFXP))[h * 256 + j] : ((const float*)(ws + WS_PFXS))[qb * 16 + h];
                ckst = (pfx + CLT[krow + tid]) * L2E; }
        }
    };
    auto tile_write = [&](int j, int buf) {
        u32x4 kw, vw;
        if (mode == 1 && j < 32) { kw = pack8(kst[0], kst[1]); vw = pack8(vst[0], vst[1]); }
        else { kw = __builtin_bit_cast(u32x4, kst[0]); vw = __builtin_bit_cast(u32x4, vst[0]); }
        *(LAS u32x4*)(lds + AT_K + buf * AT_KB + sr * 144 + sc8 * 16) = kw;
        *(LAS u32x4*)(lds + AT_V + buf * AT_VB + sr * 160 + sc8 * 16) = vw;
        if (tid < 64) *(LAS float*)(lds + AT_CK + buf * 256 + tid * 4) = ckst;
    };
    float m_run = -INFINITY, l_run = 0.f, cqm = 0.f; f32x16 o0 = {}, o1 = {};
    int jstart = 0;
    if (mode == 0 && qb > 0) {
        float dsc = 0.f;
#pragma unroll
        for (int d0 = 0; d0 < 4; ++d0) { const u32x4 kw = *(const u32x4*)(Kb + (size_t)qrow * D + h * HD + d0 * 16 + hi * 8); const u32x4 qw = __builtin_bit_cast(u32x4, qr[d0]);
            const unsigned kk[4] = {kw.x, kw.y, kw.z, kw.w}; const unsigned qq[4] = {qw.x, qw.y, qw.z, qw.w};
#pragma unroll
            for (int e = 0; e < 4; ++e) dsc += __uint_as_float(kk[e] << 16) * __uint_as_float(qq[e] << 16) + __uint_as_float(kk[e] & 0xffff0000u) * __uint_as_float(qq[e] & 0xffff0000u); }
        dsc += __shfl_xor(dsc, 32);
#pragma unroll
        for (int o = 1; o < 32; o <<= 1) dsc = fminf(dsc, __shfl_xor(dsc, o));
        float qsq = 0.f;
#pragma unroll
        for (int d0 = 0; d0 < 4; ++d0) { const u32x4 qw = __builtin_bit_cast(u32x4, qr[d0]); const unsigned qq[4] = {qw.x, qw.y, qw.z, qw.w};
#pragma unroll
            for (int e = 0; e < 4; ++e) { const float lo = __uint_as_float(qq[e] << 16), hi_ = __uint_as_float(qq[e] & 0xffff0000u); qsq += lo * lo + hi_ * hi_; } }
        qsq += __shfl_xor(qsq, 32);
#pragma unroll
        for (int o = 1; o < 32; o <<= 1) qsq = fmaxf(qsq, __shfl_xor(qsq, o));
        LAS float* red = (LAS float*)(lds + AT_END);
        if (lane == 0) { red[wave] = dsc; red[8 + wave] = qsq; }
        __syncthreads();
        float dmin = red[0], qn = red[8];
#pragma unroll
        for (int w = 1; w < 8; ++w) { dmin = fminf(dmin, red[w]); qn = fmaxf(qn, red[8 + w]); }
        const float* N2 = (const float*)(ws + WS_N2); const float* PF = (const float*)(ws + WS_PFXP) + h * 256;
        const float cq0 = (PF[qb * 4] + CLT[qb * 256]) * L2E, base = cq0 - dmin + 0.05f + 30.f;
        int cnt = 0; bool open = true;
#pragma unroll
        for (int i = 0; i < 4; ++i) { const int j = lane + 64 * i; bool sk = false;
            if (j < 4 * qb) sk = (base - PF[j + 1] * L2E + sqrtf(qn * N2[j * 32 + 16 + h]) * 1.01f) < 0.f;
            const unsigned long long m = __ballot(sk); const bool full = (m == ~0ull);
            if (open) cnt += full ? 64 : __builtin_ctzll(~m);
            open = open && full; }
        jstart = __builtin_amdgcn_readfirstlane(cnt);
    }
    tile_load(jstart); tile_write(jstart, 0); __syncthreads();
    for (int j = jstart; j < NT; ++j) {
        const int buf = (j - jstart) & 1;
        if (j + 1 < NT) tile_load(j + 1);
        const int kp0 = j * 64;
        if (active && kp0 <= qfirst + 31) {
            attn_tile(lds + AT_K + buf * AT_KB, lds + AT_V + buf * AT_VB, (const LAS f32x4*)(lds + AT_CK + buf * 256), qr, cq2, kp0, qpos, qfirst, lane, r32, hi, m_run, l_run, cqm, o0, o1);
        }
        if (j + 1 < NT) tile_write(j + 1, buf ^ 1);
        __syncthreads();
    }
    if (active) {
        const float lt = l_run + __shfl_xor(l_run, 32); const float rl = 1.0f / lt;
        bf16_t* Y = (bf16_t*)(ws + WS_YCAT) + (size_t)qrow * (2 * D) + D + h * HD;
#pragma unroll
        for (int g = 0; g < 4; ++g) {
            u32x2 w0, w1; w0.x = cvt_pk_bf16(o0[4 * g] * rl, o0[4 * g + 1] * rl); w0.y = cvt_pk_bf16(o0[4 * g + 2] * rl, o0[4 * g + 3] * rl);
            w1.x = cvt_pk_bf16(o1[4 * g] * rl, o1[4 * g + 1] * rl); w1.y = cvt_pk_bf16(o1[4 * g + 2] * rl, o1[4 * g + 3] * rl);
            *(u32x2*)(Y + 8 * g + 4 * hi) = w0; *(u32x2*)(Y + 32 + 8 * g + 4 * hi) = w1; }
    }
}

constexpr int AS_K = 0, AS_V = 2 * AT_KB, AS_CK = AS_V + 2 * AT_VB, AS_END = AS_CK + 2 * 256, AS_CMB = 34 * 64 * 4;
__device__ __forceinline__ void attn_sample_unit(const Args& a, LAS unsigned char* lds, const int h, const int b, const int tid_in, const int lane_in, const int wave) {
    int tid = tid_in; asm volatile("" : "+v"(tid)); const int lane = tid & 63;
    unsigned char* ws = a.ws;
    const bf16_t* Qb = (const bf16_t*)(ws + WS_Q); const bf16_t* Kb = (const bf16_t*)(ws + WS_K); const bf16_t* Vb = (const bf16_t*)(ws + WS_V);
    const float* CLT = (const float*)(ws + WS_CLT) + (size_t)h * M;
    const int r32 = lane & 31, hi = lane >> 5, qh = wave & 1, ks = wave >> 1;
    const int qrow = MP + b * 64 + qh * 32 + r32, qpos = PAST + qh * 32 + r32, qfirst = qpos - r32;
    const float pfs = ((const float*)(ws + WS_PFXS))[b * 16 + h];
    const float cq2 = (pfs + CLT[qrow]) * L2E;
    bf16x8 qr[4];
#pragma unroll
    for (int d0 = 0; d0 < 4; ++d0) qr[d0] = *(const bf16x8*)(Qb + (size_t)qrow * D + h * HD + d0 * 16 + hi * 8);
    const int sr = tid >> 3, sc8 = tid & 7;
    f32x4 kst[2][2], vst[2][2]; float ckst = 0.f;
    const float* pfc = (const float*)(ws + WS_PFXC) + (b * 16 + h) * 32; const float* cltc = (const float*)(ws + WS_CLTC) + (size_t)(b * 16 + h) * PAST;
    auto load2 = [&](int i) {
#pragma unroll
        for (int t = 0; t < 2; ++t) { const int j = 2 * i + t;
            if (j < 32) { const size_t off = (((size_t)(b * PAST + j * 64 + sr)) * NH + h) * HD + sc8 * 8; const float* kp = a.in[2] + off; const float* vp = a.in[3] + off;
                kst[t][0] = *(const f32x4*)kp; kst[t][1] = *(const f32x4*)(kp + 4); vst[t][0] = *(const f32x4*)vp; vst[t][1] = *(const f32x4*)(vp + 4); }
            else if (j == 32) { const size_t off = (size_t)(MP + b * 64 + sr) * D + h * HD + sc8 * 8; kst[t][0] = *(const f32x4*)(Kb + off); vst[t][0] = *(const f32x4*)(Vb + off); } }
        if (tid < 128) { const int j = 2 * i + (tid >> 6); ckst = j < 32 ? (pfc[j] + cltc[j * 64 + (tid & 63)]) * L2E : (pfs + CLT[MP + b * 64 + (tid & 63)]) * L2E; }
    };
    auto write2 = [&](int i) {
#pragma unroll
        for (int t = 0; t < 2; ++t) { const int j = 2 * i + t; u32x4 kw, vw;
            if (j < 32) { kw = pack8(kst[t][0], kst[t][1]); vw = pack8(vst[t][0], vst[t][1]); } else { kw = __builtin_bit_cast(u32x4, kst[t][0]); vw = __builtin_bit_cast(u32x4, vst[t][0]); }
            *(LAS u32x4*)(lds + AS_K + t * AT_KB + sr * 144 + sc8 * 16) = kw; *(LAS u32x4*)(lds + AS_V + t * AT_VB + sr * 160 + sc8 * 16) = vw; }
        if (tid < 128) *(LAS float*)(lds + AS_CK + tid * 4) = ckst;
    };
    float m_run = -INFINITY, l_run = 0.f, cqm = 0.f; f32x16 o0 = {}, o1 = {};
    load2(0); write2(0); __syncthreads();
    for (int i = 0; i < 17; ++i) {
        if (i + 1 < 17) load2(i + 1);
        if (ks < 2 && 2 * i + ks < 33) attn_tile(lds + AS_K + ks * AT_KB, lds + AS_V + ks * AT_VB, (const LAS f32x4*)(lds + AS_CK + ks * 256), qr, cq2, (2 * i + ks) * 64, qpos, qfirst, lane, r32, hi, m_run, l_run, cqm, o0, o1);
        __syncthreads();
        if (i + 1 < 17) { write2(i + 1); __syncthreads(); }
    }
    LAS float* cmb = (LAS float*)(lds + wave * AS_CMB);
    if (ks == 1) { cmb[lane] = m_run; cmb[64 + lane] = l_run;
#pragma unroll
        for (int r = 0; r < 16; ++r) { cmb[(2 + r) * 64 + lane] = o0[r]; cmb[(18 + r) * 64 + lane] = o1[r]; } }
    __syncthreads();
    if (ks == 0) {
#pragma unroll
        for (int k = 1; k < 2; ++k) { const LAS float* c = (const LAS float*)(lds + (qh + 2 * k) * AS_CMB);
            const float mk = c[lane], lk = c[64 + lane], mn = fmaxf(m_run, mk), fa = __builtin_amdgcn_exp2f(m_run - mn), fb = __builtin_amdgcn_exp2f(mk - mn);
            l_run = l_run * fa + lk * fb; m_run = mn;
#pragma unroll
            for (int r = 0; r < 16; ++r) { o0[r] = o0[r] * fa + c[(2 + r) * 64 + lane] * fb; o1[r] = o1[r] * fa + c[(18 + r) * 64 + lane] * fb; } }
        const float lt = l_run + __shfl_xor(l_run, 32); const float rl = 1.0f / lt;
        bf16_t* Y = (bf16_t*)(ws + WS_YCAT) + (size_t)qrow * (2 * D) + D + h * HD;
#pragma unroll
        for (int g = 0; g < 4; ++g) {
            u32x2 w0, w1; w0.x = cvt_pk_bf16(o0[4 * g] * rl, o0[4 * g + 1] * rl); w0.y = cvt_pk_bf16(o0[4 * g + 2] * rl, o0[4 * g + 3] * rl);
            w1.x = cvt_pk_bf16(o1[4 * g] * rl, o1[4 * g + 1] * rl); w1.y = cvt_pk_bf16(o1[4 * g + 2] * rl, o1[4 * g + 3] * rl);
            *(u32x2*)(Y + 8 * g + 4 * hi) = w0; *(u32x2*)(Y + 32 + 8 * g + 4 * hi) = w1; }
    }
    __syncthreads();
}

constexpr int LR_XCB = 0  , LR_XCF = 9216  , LR_A = LR_XCF + 64 * 68 * 4  , LR_B = LR_A + 16384, LR_SA = LR_B + 16384  , LR_SB = LR_SA + 2048, LR_HC = LR_SB + 2048  , LR_PC = LR_HC + 512, LR_END = LR_PC + 512;
__device__ __forceinline__ void lru_item(const Args& a, LAS unsigned char* lds, const int s, const int seg, const int hb, const int tid_in, const int lane_in, const int wave) {
    int tid = tid_in; asm volatile("" : "+v"(tid)); const int lane = tid & 63;
    unsigned char* ws = a.ws;
    const bf16_t* XR = (const bf16_t*)(ws + WS_XR); const bf16_t* GATE = (const bf16_t*)(ws + WS_GATE); bf16_t* YL = (bf16_t*)(ws + WS_YCAT); bf16_t* PB = (bf16_t*)(ws + WS_PB); bf16_t* HL = (bf16_t*)(ws + WS_HL);
    const bool fin = s != 0;
    const int nch = s == 0 ? SEGCH : 1, row0 = s == 0 ? 0 : MP + (s - 1) * 64, tb = s == 0 ? seg * SEGLEN : 0;
    const int c0 = hb * 64;
    const int ct = tid >> 3, cg8 = tid & 7, cch = c0 + cg8 * 8;
    float cw[4][8], cb[8];
#pragma unroll
    for (int j = 0; j < 4; ++j) { const f32x4 w0 = *(const f32x4*)(a.in[11] + j * D + cch), w1 = *(const f32x4*)(a.in[11] + j * D + cch + 4);
#pragma unroll
        for (int i = 0; i < 4; ++i) { cw[j][i] = w0[i]; cw[j][4 + i] = w1[i]; } }
    { const f32x4 b0 = *(const f32x4*)(a.in[12] + cch), b1 = *(const f32x4*)(a.in[12] + cch + 4);
#pragma unroll
      for (int i = 0; i < 4; ++i) { cb[i] = b0[i]; cb[4 + i] = b1[i]; } }
    const int jt = wave & 3, mt0 = 2 * (wave >> 2), fr = lane & 15, fq = lane >> 4;
    bf16x8 brg[2], big[2];
    { const float* wr_ = a.in[13] + (size_t)hb * 4096 + jt * 16 + fr; const float* wi_ = a.in[15] + (size_t)hb * 4096 + jt * 16 + fr;
#pragma unroll
      for (int ks = 0; ks < 2; ++ks) { u32x4 r, q; float tr[8], ti[8];
#pragma unroll
          for (int e = 0; e < 8; ++e) { const int i = 32 * ks + 8 * fq + e; tr[e] = wr_[i * 64]; ti[e] = wi_[i * 64]; }
          r.x = cvt_pk_bf16(tr[0], tr[1]); r.y = cvt_pk_bf16(tr[2], tr[3]); r.z = cvt_pk_bf16(tr[4], tr[5]); r.w = cvt_pk_bf16(tr[6], tr[7]);
          q.x = cvt_pk_bf16(ti[0], ti[1]); q.y = cvt_pk_bf16(ti[2], ti[3]); q.z = cvt_pk_bf16(ti[4], ti[5]); q.w = cvt_pk_bf16(ti[6], ti[7]);
          brg[ks] = __builtin_bit_cast(bf16x8, r); big[ks] = __builtin_bit_cast(bf16x8, q); } }
    const int ej = c0 + jt * 16 + fr;
    const float e_brg = a.in[14][ej], e_big = a.in[16][ej];
    float e_ls; { const float lam = a.in[17][ej]; e_ls = 8.0f * (fminf(lam, 0.f) - log1pf(expf(-fabsf(lam)))) * L2E; }
    const int sj = tid & 63, sseg = tid >> 6;
    LAS bf16_t* xcb = (LAS bf16_t*)(lds + LR_XCB); LAS float* xcf = (LAS float*)(lds + LR_XCF); LAS float* LA = (LAS float*)(lds + LR_A); LAS float* LB = (LAS float*)(lds + LR_B);
    LAS float* SA = (LAS float*)(lds + LR_SA); LAS float* SB = (LAS float*)(lds + LR_SB); LAS float* HC = (LAS float*)(lds + LR_HC); LAS float* PC = (LAS float*)(lds + LR_PC);
    if (tid < 64) { HC[tid] = fin ? a.in[6][(size_t)(s - 1) * D + c0 + tid] : 0.f; PC[tid] = 1.f; }
    u32x4 xr[4]; bf16_t gt[8];
    auto prefetch = [&](int k) {
        const int t0 = tb + k * 64 + ct;
#pragma unroll
        for (int j = 0; j < 4; ++j) { const int tt = t0 + j - 3;
            if (tt >= 0) xr[j] = *(const u32x4*)(XR + (size_t)(row0 + tt) * D + cch); else xr[j] = (u32x4){0u, 0u, 0u, 0u}; }
        if (fin) {
#pragma unroll
            for (int i = 0; i < 8; ++i) gt[i] = GATE[(size_t)(row0 + tb + k * 64 + sseg * 8 + i) * D + c0 + sj]; }
    };
    prefetch(0);
    for (int k = 0; k < nch; ++k) {
        { float xc[8];
#pragma unroll
          for (int i = 0; i < 8; ++i) xc[i] = cb[i];
#pragma unroll
          for (int j = 0; j < 4; ++j) { float xv[8]; const int tt = tb + k * 64 + ct + j - 3;
              if (fin && tt < 0) { const float* sp = a.in[5] + ((size_t)(s - 1) * 3 + (tt + 3)) * D + cch; const f32x4 q0 = *(const f32x4*)sp, q1 = *(const f32x4*)(sp + 4);
#pragma unroll
                  for (int i = 0; i < 4; ++i) { xv[i] = q0[i]; xv[4 + i] = q1[i]; } }
              else { const u32x4 w = xr[j];
                  xv[0] = __uint_as_float(w.x << 16); xv[1] = __uint_as_float(w.x & 0xffff0000u); xv[2] = __uint_as_float(w.y << 16); xv[3] = __uint_as_float(w.y & 0xffff0000u);
                  xv[4] = __uint_as_float(w.z << 16); xv[5] = __uint_as_float(w.z & 0xffff0000u); xv[6] = __uint_as_float(w.w << 16); xv[7] = __uint_as_float(w.w & 0xffff0000u); }
#pragma unroll
              for (int i = 0; i < 8; ++i) xc[i] += xv[i] * cw[j][i]; }
          u32x4 pw; pw.x = cvt_pk_bf16(xc[0], xc[1]); pw.y = cvt_pk_bf16(xc[2], xc[3]); pw.z = cvt_pk_bf16(xc[4], xc[5]); pw.w = cvt_pk_bf16(xc[6], xc[7]);
          *(LAS u32x4*)(xcb + ct * 72 + cg8 * 8) = pw;
          *(LAS f32x4*)(xcf + ct * 68 + cg8 * 8) = (f32x4){xc[0], xc[1], xc[2], xc[3]}; *(LAS f32x4*)(xcf + ct * 68 + cg8 * 8 + 4) = (f32x4){xc[4], xc[5], xc[6], xc[7]}; }
        bf16_t gcur[8];
#pragma unroll
        for (int i = 0; i < 8; ++i) gcur[i] = gt[i];
        __syncthreads();
        if (k + 1 < nch) prefetch(k + 1);
#pragma unroll
        for (int mi = 0; mi < 2; ++mi) { const int mt = mt0 + mi; f32x4 pr = {0.f, 0.f, 0.f, 0.f}, pi = {0.f, 0.f, 0.f, 0.f};
#pragma unroll
            for (int ks = 0; ks < 2; ++ks) { const bf16x8 af = *(const LAS bf16x8*)(xcb + (mt * 16 + fr) * 72 + ks * 32 + fq * 8);
                pr = __builtin_amdgcn_mfma_f32_16x16x32_bf16(af, brg[ks], pr, 0, 0, 0); pi = __builtin_amdgcn_mfma_f32_16x16x32_bf16(af, big[ks], pi, 0, 0, 0); }
#pragma unroll
            for (int i = 0; i < 4; ++i) { const int t = mt * 16 + 4 * fq + i;
                const float r = fast_sigmoid(pr[i] + e_brg), ig = fast_sigmoid(pi[i] + e_big);
                const float av = __builtin_amdgcn_exp2f(r * e_ls);
                float mult = sqrtf(fmaxf(1.f - av * av, 0.f));
                if (!fin && tb + k * 64 + t == 0) mult = 1.f;
                const float xcv = xcf[t * 68 + jt * 16 + fr];
                LA[t * 64 + jt * 16 + fr] = av; LB[t * 64 + jt * 16 + fr] = mult * ig * xcv; } }
        __syncthreads();
        float av[8], bv[8];
        { float Ap = 1.f, Bp = 0.f;
#pragma unroll
          for (int i = 0; i < 8; ++i) { av[i] = LA[(sseg * 8 + i) * 64 + sj]; bv[i] = LB[(sseg * 8 + i) * 64 + sj]; Bp = av[i] * Bp + bv[i]; Ap *= av[i]; }
          SA[sseg * 64 + sj] = Ap; SB[sseg * 64 + sj] = Bp; }
        __syncthreads();
        { float hv = HC[(k & 1) * 64 + sj], pv = PC[(k & 1) * 64 + sj];
#pragma unroll
          for (int q = 0; q < 8; ++q) { const float A_ = SA[q * 64 + sj], B_ = SB[q * 64 + sj]; if (q < sseg) { hv = A_ * hv + B_; pv *= A_; } }
          const size_t ob = (size_t)(row0 + tb + k * 64 + sseg * 8) * D + c0 + sj;
#pragma unroll
          for (int i = 0; i < 8; ++i) { hv = av[i] * hv + bv[i]; pv *= av[i];
              if (fin) { const float g = __uint_as_float((unsigned)gcur[i] << 16); YL[(size_t)(row0 + tb + k * 64 + sseg * 8 + i) * (2 * D) + c0 + sj] = (bf16_t)(cvt_pk_bf16(hv * g, 0.f) & 0xffffu); }
              else { const unsigned w = cvt_pk_bf16(hv, pv); HL[ob + (size_t)i * D] = (bf16_t)(w & 0xffffu); PB[ob + (size_t)i * D] = (bf16_t)(w >> 16); } }
          if (sseg == 7) { HC[((k + 1) & 1) * 64 + sj] = hv; PC[((k + 1) & 1) * 64 + sj] = pv;
              if (k + 1 == nch) { if (fin) a.out[O_HS + (size_t)(s - 1) * D + c0 + sj] = hv;
                  else { float* ag = (float*)(ws + WS_AGG) + (size_t)seg * 2048 + c0 + sj; ag[0] = pv; ag[1024] = hv; } } } }
    }
    if (!fin) {
        asm volatile("s_waitcnt vmcnt(0)" ::: "memory"); __syncthreads();
        if (tid == 0) { __builtin_amdgcn_fence(__ATOMIC_RELEASE, "agent"); asm volatile("s_waitcnt vmcnt(0)" ::: "memory");
            __hip_atomic_store((unsigned*)(ws + WS_FLAG) + seg * 16 + hb, 1u, __ATOMIC_RELAXED, __HIP_MEMORY_SCOPE_AGENT); } }
    __syncthreads();
}
__device__ __forceinline__ void lru_fix_item(const Args& a, const int seg, const int hb, const int tid_in) {
    int tid = tid_in; asm volatile("" : "+v"(tid));
    unsigned char* ws = a.ws;
    if (tid == 0) { unsigned* fl = (unsigned*)(ws + WS_FLAG) + hb;
        for (int q = 0; q <= seg; ++q) while (__hip_atomic_load(fl + q * 16, __ATOMIC_RELAXED, __HIP_MEMORY_SCOPE_AGENT) == 0u) __builtin_amdgcn_s_sleep(4);
        __builtin_amdgcn_fence(__ATOMIC_ACQUIRE, "agent"); asm volatile("s_waitcnt vmcnt(0)" ::: "memory"); }
    __syncthreads();
    const int cg8 = tid & 7, cch = hb * 64 + cg8 * 8, r0 = tid >> 3;
    float hin[8];
#pragma unroll
    for (int i = 0; i < 8; ++i) hin[i] = 0.f;
    const float* ag = (const float*)(ws + WS_AGG) + cch;
    for (int q = 0; q < seg; ++q) { const f32x4 A0 = *(const f32x4*)(ag + q * 2048), A1 = *(const f32x4*)(ag + q * 2048 + 4), B0 = *(const f32x4*)(ag + q * 2048 + 1024), B1 = *(const f32x4*)(ag + q * 2048 + 1028);
#pragma unroll
        for (int i = 0; i < 4; ++i) { hin[i] = A0[i] * hin[i] + B0[i]; hin[4 + i] = A1[i] * hin[4 + i] + B1[i]; } }
    if (seg == NSEG - 1 && r0 == 0) { const int q = seg; const f32x4 A0 = *(const f32x4*)(ag + q * 2048), A1 = *(const f32x4*)(ag + q * 2048 + 4), B0 = *(const f32x4*)(ag + q * 2048 + 1024), B1 = *(const f32x4*)(ag + q * 2048 + 1028);
        f32x4 h0, h1;
#pragma unroll
        for (int i = 0; i < 4; ++i) { h0[i] = A0[i] * hin[i] + B0[i]; h1[i] = A1[i] * hin[4 + i] + B1[i]; }
        *(f32x4*)(a.out + O_HP + cch) = h0; *(f32x4*)(a.out + O_HP + cch + 4) = h1; }
    bf16_t* YL = (bf16_t*)(ws + WS_YCAT); const bf16_t* HL = (const bf16_t*)(ws + WS_HL); const bf16_t* PB = (const bf16_t*)(ws + WS_PB); const bf16_t* GATE = (const bf16_t*)(ws + WS_GATE);
#pragma unroll 4
    for (int i = 0; i < SEGLEN / 64; ++i) { const size_t off = (size_t)(seg * SEGLEN + r0 + 64 * i) * D + cch;
        const u32x4 hl = *(const u32x4*)(HL + off), pp = *(const u32x4*)(PB + off), gg = *(const u32x4*)(GATE + off);
        u32x4 o; const unsigned* hw = (const unsigned*)&hl; const unsigned* pw = (const unsigned*)&pp; const unsigned* gw = (const unsigned*)&gg; unsigned* ow = (unsigned*)&o;
#pragma unroll
        for (int e = 0; e < 4; ++e) { const float y0 = (__uint_as_float(hw[e] << 16) + __uint_as_float(pw[e] << 16) * hin[2 * e]) * __uint_as_float(gw[e] << 16);
            const float y1 = (__uint_as_float(hw[e] & 0xffff0000u) + __uint_as_float(pw[e] & 0xffff0000u) * hin[2 * e + 1]) * __uint_as_float(gw[e] & 0xffff0000u);
            ow[e] = cvt_pk_bf16(y0, y1); }
        *(u32x4*)(YL + (size_t)(seg * SEGLEN + r0 + 64 * i) * (2 * D) + cch) = o; }
}

__device__ __forceinline__ void norm_pass(const Args& a, LAS unsigned char* lds, int tid, int lane, int wave) {
    unsigned char* ws = a.ws; LAS float* red = (LAS float*)lds;
    for (int b = blockIdx.x; b < MP / 64; b += gridDim.x) {
#pragma unroll
        for (int kind = 1; kind < 2; ++kind) { const bf16_t* X = (const bf16_t*)(ws + WS_K); float mx = 0.f;
#pragma unroll
            for (int i = 0; i < 8; ++i) { const bf16_t* p = X + (size_t)(b * 64 + wave * 8 + i) * D + lane * 16; const u32x4 w0 = *(const u32x4*)p, w1 = *(const u32x4*)(p + 8); float sq = 0.f;
                const unsigned ww[8] = {w0.x, w0.y, w0.z, w0.w, w1.x, w1.y, w1.z, w1.w};
#pragma unroll
                for (int e = 0; e < 8; ++e) { const float lo = __uint_as_float(ww[e] << 16), hi = __uint_as_float(ww[e] & 0xffff0000u); sq += lo * lo + hi * hi; }
                sq += __shfl_xor(sq, 1); sq += __shfl_xor(sq, 2); mx = fmaxf(mx, sq); }
            if ((lane & 3) == 0) red[(wave * 2 + kind) * 16 + (lane >> 2)] = mx; }
        __syncthreads();
        if (tid >= 16 && tid < 32) { float m = 0.f;
#pragma unroll
            for (int w = 0; w < 8; ++w) m = fmaxf(m, red[(w * 2 + (tid >> 4)) * 16 + (tid & 15)]);
            ((float*)(ws + WS_N2))[b * 32 + tid] = m; }
        __syncthreads();
    }
}

#define XB_TMO      128
#define XB_XCNT(j)  (256  + 64 * (j))
#define XB_XSUB(j)  (1280 + 64 * (j))
#define XB_XGEN(j)  (2304 + 64 * (j))
#define XB_TOP      3328
#define XB_TOPGEN   3392
#define XCD_BAR_WORDS 3456
#define XB_SPIN_CAP (1u << 18)
__device__ __forceinline__ unsigned xb_ld(unsigned* p)              { return __hip_atomic_load(p, __ATOMIC_RELAXED, __HIP_MEMORY_SCOPE_AGENT); }
__device__ __forceinline__ unsigned xb_add(unsigned* p, unsigned v) { return __hip_atomic_fetch_add(p, v, __ATOMIC_RELAXED, __HIP_MEMORY_SCOPE_AGENT); }
__device__ __forceinline__ unsigned xb_xcc_id() { return (unsigned)__builtin_amdgcn_s_getreg((3 << 11) | 20) & 0xFu; }
#define XB_SPIN(cond, bar) do { unsigned _sp = 0; while (cond) { __builtin_amdgcn_s_sleep(1); \
    if ((++_sp & 255u) == 0u) { if (xb_ld(&(bar)[XB_TMO])) break; if (_sp > XB_SPIN_CAP) { atomicAdd(&(bar)[XB_TMO], 1u); break; } } } } while (0)
struct XcdBarrier { unsigned* bar; unsigned x; volatile LAS unsigned* st; };
__device__ __forceinline__ XcdBarrier xcd_barrier_post(unsigned* bar, volatile LAS unsigned* st) {
    XcdBarrier b; b.bar = bar; b.x = xb_xcc_id(); b.st = st;
    if (threadIdx.x == 0) (void)xb_add(&bar[XB_XCNT(b.x)], 1u);
    return b;
}
__device__ __forceinline__ void xcd_barrier_complete(unsigned* bar, unsigned x, unsigned& nloc, unsigned& nx) {
    const unsigned G = gridDim.x * gridDim.y * gridDim.z;
    unsigned sum, cnt, mine, sp = 0u;
    for (;;) {
        sum = 0u; cnt = 0u; mine = 0u;
#pragma unroll
        for (unsigned j = 0; j < 16; ++j) { const unsigned c = xb_ld(&bar[XB_XCNT(j)]); sum += c; cnt += (c > 0u) ? 1u : 0u; mine = (j == x) ? c : mine; }
        if (sum == G) break;
        __builtin_amdgcn_s_sleep(1);
        if ((++sp & 255u) == 0u) { if (xb_ld(&bar[XB_TMO])) break; if (sp > XB_SPIN_CAP) { atomicAdd(&bar[XB_TMO], 1u); break; } }
    }
    nloc = mine > 0u ? mine : 1u; nx = cnt > 0u ? cnt : 1u;
}
__device__ __forceinline__ void xcd_barrier(const XcdBarrier& b) {
    asm volatile("s_waitcnt vmcnt(0)" ::: "memory");
    __syncthreads();
    if (threadIdx.x == 0) {
        unsigned* bar = b.bar;
        __builtin_amdgcn_s_waitcnt(0);
        unsigned nloc = b.st[0], nx = b.st[1];
        if (nloc == 0u) { xcd_barrier_complete(bar, b.x, nloc, nx); b.st[0] = nloc; b.st[1] = nx; }
        const unsigned old = xb_add(&bar[XB_XSUB(b.x)], 1u);
        const unsigned gen = old / nloc;
        if (old + 1u == (gen + 1u) * nloc) {
            __builtin_amdgcn_fence(__ATOMIC_RELEASE, "agent");
            asm volatile("s_waitcnt vmcnt(0)" ::: "memory");
            const unsigned og = xb_add(&bar[XB_TOP], 1u);
            const unsigned tg = og / nx;
            if (og + 1u == (tg + 1u) * nx) xb_add(&bar[XB_TOPGEN], 1u);
            else XB_SPIN(xb_ld(&bar[XB_TOPGEN]) == tg, bar);
            __builtin_amdgcn_fence(__ATOMIC_ACQUIRE, "agent");
            xb_add(&bar[XB_XGEN(b.x)], 1u);
            asm volatile("s_waitcnt vmcnt(0)" ::: "memory");
        } else {
            XB_SPIN(xb_ld(&bar[XB_XGEN(b.x)]) == gen, bar);
            __builtin_amdgcn_fence(__ATOMIC_ACQUIRE, "agent");
            asm volatile("s_waitcnt vmcnt(0)" ::: "memory");
        }
    }
    __syncthreads();
}

__global__ void __launch_bounds__(512, 2) fwd_megakernel(Args a) {
    extern __shared__ __attribute__((aligned(16))) unsigned char lds_raw[];
    LAS unsigned char* lds = (LAS unsigned char*)lds_raw;
    cg::grid_group grid = cg::this_grid();
    const int tid = threadIdx.x, lane = tid & 63, wave = __builtin_amdgcn_readfirstlane(tid >> 6);
    unsigned char* ws = a.ws;
    const int lo = a.ph_lo, hi = a.ph_hi;
#define IN(k) (lo <= (k) && (k) < hi)
    { volatile LAS unsigned* st = (volatile LAS unsigned*)(lds + 144000); if (tid < 2) st[tid] = 0u; }
    __syncthreads();
    const XcdBarrier xbar = xcd_barrier_post((unsigned*)(ws + WS_BAR), (volatile LAS unsigned*)(lds + 144000));
#define SEAM(k) do { xcd_barrier(xbar); } while (0)
    if (a.ph_lo > 1000) grid.sync();
    if (IN(0)) { p0_phase(a, lds, tid, lane, wave); }
    SEAM(0);
    if (IN(1)) {
        pg8::Gemm g{(const bf16_t*)(ws + WS_XN), (const bf16_t*)(ws + WS_WIN), M, NIN, D}; pg8::StaticOrder S; S.init(M, NIN, gridDim.x, blockIdx.x);
        EpiIn E{(bf16_t*)(ws + WS_XR), (bf16_t*)(ws + WS_GATE), (bf16_t*)(ws + WS_Q), (bf16_t*)(ws + WS_K), (bf16_t*)(ws + WS_V), (bf16_t*)(ws + WS_G), a.out, a.in[10]};
        pg8::gemm_phase<EpiIn>(lds, g, S, E);
        if (blockIdx.x == gridDim.x - 1) prefix_task(a, lds, tid);
    }
    SEAM(1);
    if (IN(2)) {
        norm_pass(a, lds, tid, lane, wave);
        xcd_barrier(xbar);
        constexpr int N_LRUA = NSEG * 16, N_ATTP = 64 * 16, N_ATTS = 256, N_LRUS = 256, N_LRUB = NSEG * 16;
        constexpr int Q1 = N_LRUA, Q2 = Q1 + N_ATTP, Q3 = Q2 + N_ATTS, Q4 = Q3 + N_LRUS, NITEMS = Q4 + N_LRUB;
        LAS int* slot = (LAS int*)(lds + 140 * 1024);
        for (;;) {
            if (tid == 0) *slot = (int)atomicAdd((unsigned*)(ws + WS_CTL), 1u);
            __syncthreads();
            const int it0 = __builtin_amdgcn_readfirstlane(*slot);
            __syncthreads();
            if (it0 >= NITEMS) break;
            int it = it0;
            if (it0 >= Q1 && it0 < Q3) { const int idx = it0 - Q1, grp = (int)(((unsigned)idx * 52429u) >> 18), r = idx - grp * 5;
                it = r < 4 ? Q1 + grp * 4 + r : Q2 + grp; }
            if (it < Q1) lru_item(a, lds, 0, it >> 4, it & 15, tid, lane, wave);
            else if (it < Q2) { const int i = it - Q1; attn_unit(a, lds, 0, i & 15, 63 - (i >> 4), tid, lane, wave); }
            else if (it < Q3) { const int i = it - Q2; attn_sample_unit(a, lds, i & 15, i >> 4, tid, lane, wave); }
            else if (it < Q4) { const int i = it - Q3; lru_item(a, lds, 1 + (i >> 4), 0, i & 15, tid, lane, wave); }
            else { const int i = it - Q4; lru_fix_item(a, i >> 4, i & 15, tid); }
        }
    }
    SEAM(2);
    if (IN(3)) {
        pg8::Gemm g{(const bf16_t*)(ws + WS_YCAT), (const bf16_t*)(ws + WS_WCAT), M, D, 2 * D}; pg8::StaticOrder S; S.init(M, D, gridDim.x, blockIdx.x);
        EpiMerge E{(const bf16_t*)(ws + WS_G), (bf16_t*)(ws + WS_MIXED)};
        pg8::gemm_phase<EpiMerge>(lds, g, S, E);
    }
    SEAM(3);
    if (IN(4)) {
        pg8::Gemm g{(const bf16_t*)(ws + WS_MIXED), (const bf16_t*)(ws + WS_WOUT), M, D, D}; pg8::StaticOrder S; S.init(M, D, gridDim.x, blockIdx.x);
        EpiOut E{a.in[0], a.in[1], (bf16_t*)(ws + WS_X2), (float*)(ws + WS_RSS2)};
        pg8::gemm_phase<EpiOut>(lds, g, S, E);
    }
    SEAM(4);
    if (IN(5)) {
        pg8::Gemm g{(const bf16_t*)(ws + WS_X2), (const bf16_t*)(ws + WS_WFFI), M, 2 * DFF, D}; pg8::StaticOrder S; S.init(M, 2 * DFF, gridDim.x, blockIdx.x);
        EpiFfnIn E{(const float*)(ws + WS_RSS2), (bf16_t*)(ws + WS_HFF)};
        pg8::gemm_phase<EpiFfnIn>(lds, g, S, E);
    }
    SEAM(5);
    if (IN(6)) {
        pg8::Gemm g{(const bf16_t*)(ws + WS_HFF), (const bf16_t*)(ws + WS_WFFO), M, D, DFF}; pg8::StaticOrder S; S.init(M, D, gridDim.x, blockIdx.x);
        EpiFfnOut E{(const bf16_t*)(ws + WS_X2), (bf16_t*)(ws + WS_XG), (float*)(ws + WS_RSS3)};
        pg8::gemm_phase<EpiFfnOut>(lds, g, S, E);
    }
    SEAM(6);
    if (IN(7)) {
        const float* rss = (const float*)(ws + WS_RSS3); const float* gf = a.in[24];
        f32x4 gv[4];
#pragma unroll
        for (int j = 0; j < 4; ++j) gv[j] = *(const f32x4*)(gf + 4 * lane + 256 * j);
        for (int row = blockIdx.x * 8 + wave; row < M; row += gridDim.x * 8) {
            const float rstd = 1.0f / sqrtf(rss[row] * (1.f / D) + EPS); float* y = a.out + O_Y + (size_t)row * D + 4 * lane; const bf16_t* x3 = (const bf16_t*)(ws + WS_XG) + (size_t)row * D + 4 * lane;
#pragma unroll
            for (int j = 0; j < 4; ++j) { const u32x2 w = *(const u32x2*)(x3 + 256 * j);
                f32x4 v = {__uint_as_float(w.x << 16), __uint_as_float(w.x & 0xffff0000u), __uint_as_float(w.y << 16), __uint_as_float(w.y & 0xffff0000u)};
                *(f32x4*)(y + 256 * j) = v * rstd * gv[j]; }
        }
    }
#undef IN
#undef SEAM
}

extern "C" void kernel_launch(void* const* d_in, const int* in_sizes, int n_in, void* d_out, int out_size, void* d_ws, size_t ws_size, hipStream_t stream) {
    static int grid = 0;
    if (grid == 0) {
        if (n_in != 25 || (size_t)out_size != O_END || ws_size < WS_END) { fprintf(stderr, "kernel_launch: unexpected shapes: n_in %d out %d (want %zu) ws %zu (want %zu)\n", n_in, out_size, (size_t)O_END, ws_size, (size_t)WS_END); grid = -1; return; }
        int dev = 0, cus = 0, per_cu = 0;
        (void)hipGetDevice(&dev); (void)hipDeviceGetAttribute(&cus, hipDeviceAttributeMultiprocessorCount, dev);
        if (hipFuncSetAttribute((const void*)fwd_megakernel, hipFuncAttributeMaxDynamicSharedMemorySize, LDS_BYTES) != hipSuccess) { fprintf(stderr, "kernel_launch: hipFuncSetAttribute failed\n"); grid = -1; return; }
        if (hipOccupancyMaxActiveBlocksPerMultiprocessor(&per_cu, (const void*)fwd_megakernel, 512, LDS_BYTES) != hipSuccess || per_cu < 1) { fprintf(stderr, "kernel_launch: occupancy query failed (%d)\n", per_cu); (void)hipGetLastError(); per_cu = 1; }
        grid = cus * 1;
        fprintf(stderr, "kernel_launch: cus %d per_cu %d grid %d\n", cus, per_cu, grid);
    }
    if (grid < 0) return;
    Args a{};
    for (int i = 0; i < 25; ++i) a.in[i] = (const float*)d_in[i];
    a.out = (float*)d_out; a.ws = (unsigned char*)d_ws; a.ph_lo = 0; a.ph_hi = 8;
    if (hipMemsetAsync((char*)d_ws + WS_BAR, 0, 16 * 1024, stream) != hipSuccess) { fprintf(stderr, "kernel_launch: memset failed\n"); return; }
    void* args[] = {&a};
    hipError_t e = hipLaunchCooperativeKernel((const void*)fwd_megakernel, dim3(grid), dim3(512), args, LDS_BYTES, stream);
    if (e != hipSuccess) fprintf(stderr, "kernel_launch: cooperative launch failed: %s (grid %d)\n", hipGetErrorString(e), grid);
}
```

```cpp
#include <hip/hip_runtime.h>
#include <hip/hip_cooperative_groups.h>
#include <cstdio>
#include <cstdint>
namespace cg = cooperative_groups;

#define LAS __attribute__((address_space(3)))
typedef unsigned short bf16_t;
typedef short bf16x8 __attribute__((ext_vector_type(8)));
typedef float f32x4 __attribute__((ext_vector_type(4)));
typedef float f32x2 __attribute__((ext_vector_type(2)));
typedef float f32x16 __attribute__((ext_vector_type(16)));
typedef unsigned u32x4 __attribute__((ext_vector_type(4)));
typedef unsigned u32x2 __attribute__((ext_vector_type(2)));
typedef short v4i16_t __attribute__((ext_vector_type(4)));

constexpr int MP = 16384, MS = 1024, M = MP + MS, D = 1024, NH = 16, HD = 64, DFF = 2816, DIN = 7184, NIN = 7168, PAST = 2048;
constexpr float EPS = 1e-6f, L2E = 1.4426950408889634f, QSCALE = 0.125f * 1.4426950408889634f;
constexpr size_t O_Y = 0, O_KP = (size_t)M * D, O_VP = O_KP + (size_t)MP * D, O_LFP = O_VP + (size_t)MP * D, O_CVP = O_LFP + (size_t)MP * NH,
                 O_HP = O_CVP + 3 * D, O_KS = O_HP + D, O_VS = O_KS + (size_t)MS * D, O_LFS = O_VS + (size_t)MS * D, O_CVS = O_LFS + (size_t)MS * NH,
                 O_HS = O_CVS + 16 * 3 * D, O_END = O_HS + 16 * D;
constexpr size_t MiB = 1u << 20;
constexpr size_t WS_CTL = 0, WS_RSS2 = 1 * MiB, WS_RSS3 = WS_RSS2 + 128 * 1024, WS_CSP = WS_RSS3 + 128 * 1024  , WS_CSC = WS_CSP + 32 * 1024  ,
                 WS_PFXP = WS_CSC + 64 * 1024  , WS_PFXC = WS_PFXP + 32 * 1024  , WS_PFXS = WS_PFXC + 64 * 1024  ,
                 WS_CLT = 2 * MiB  , WS_CLTC = 4 * MiB  ,
                 WS_WIN = 8 * MiB, WS_WCAT = 22 * MiB  , WS_WOUT = 26 * MiB, WS_WFFI = 28 * MiB, WS_WFFO = 39 * MiB,
                 WS_XN = 48 * MiB, WS_MIXED = 48 * MiB, WS_XR = 82 * MiB, WS_T1 = 82 * MiB, WS_GATE = 116 * MiB, WS_Q = 150 * MiB, WS_XG = 150 * MiB,
                 WS_K = 184 * MiB, WS_HFF = 184 * MiB, WS_V = 218 * MiB, WS_G = 252 * MiB, WS_YCAT = 320 * MiB  , WS_X2 = 388 * MiB, WS_HL = 388 * MiB, WS_PB = 422 * MiB, WS_END = 456 * MiB;
constexpr size_t WS_BAR = 16 * 1024;
constexpr size_t WS_N2 = WS_PFXS + 4096 + 128 * 1024  , WS_FLAG = WS_BAR + 15 * 1024  , WS_AGG = WS_PFXS + 4096  ;
constexpr int NSEG = 16, SEGLEN = MP / NSEG, SEGCH = SEGLEN / 64;
constexpr int LDS_BYTES = 147456;

struct Args { const float* in[25]; float* out; unsigned char* ws; int ph_lo, ph_hi; };

namespace pg8 {
constexpr int BM = 256, BK = 64, HALF = 128, HTB = HALF * BK * 2, STAGE_BYTES = 8 * HTB, NXCD = 8, WGM = 8;
__host__ __device__ __forceinline__ int lds_byte(int r, int c) { const int st = (r >> 4) * 2 + (c >> 5), rr = r & 15, cc = c & 31, ob = rr * 64 + cc * 2; return st * 1024 + (ob ^ (((ob >> 9) & 1) << 5)); }
__host__ __device__ __forceinline__ void stage_rc(int b, int& R, int& C) { const int st = b / 1024, sb = b % 1024, swz = sb ^ (((sb >> 9) & 1) << 5); R = (st >> 1) * 16 + swz / 64; C = (st & 1) * 32 + (swz % 64) / 2; }
__host__ __device__ __forceinline__ int perm32(int rho) { const int n = rho >> 4, i = rho & 15; return 8 * (i >> 2) + 4 * n + (i & 3); }
struct Unit { int pm, pn; };
struct Gemm { const bf16_t* A; const bf16_t* Bt; int M, N, K; };
struct StaticOrder {
    int nM, nN, nwg, G, c;
    __device__ void init(int M_, int N_, int G_, int c_) { nM = M_ / BM; nN = N_ / BM; nwg = nM * nN; G = G_; c = c_; }
    __device__ bool next(int i, Unit& u) const {
        const long L = (long)i * G + c; if (L >= nwg) return false;
        int wgid = (int)L; { const int q = nwg / NXCD, r = nwg % NXCD, xcd = wgid % NXCD, off = wgid / NXCD; wgid = (xcd < r ? xcd * (q + 1) : r * (q + 1) + (xcd - r) * q) + off; }
        const int nig = WGM * nN, gid = wgid / nig, fm = gid * WGM, gsz = (nM - fm) < WGM ? (nM - fm) : WGM;
        u.pm = fm + ((wgid % nig) % gsz); u.pn = (wgid % nig) / gsz; return true;
    }
};
__device__ __forceinline__ unsigned cvt_pk_bf16(float lo, float hi) { unsigned r; asm volatile("v_cvt_pk_bf16_f32 %0, %1, %2" : "=v"(r) : "v"(lo), "v"(hi)); return r; }

template <class Epi>
__device__ __forceinline__ void gemm_phase(LAS unsigned char* lds, const Gemm g, const StaticOrder& S, const Epi& E) {
    const int tid = threadIdx.x, wid = __builtin_amdgcn_readfirstlane(tid >> 6), lane = tid & 63, wr = wid >> 2, wc = wid & 3, fr = lane & 15, fq = lane >> 4;
    const int K = g.K, nt = K / BK;
    unsigned voffA[2], voffB[2];
#pragma unroll
    for (int i = 0; i < 2; ++i) { int R, C; stage_rc(tid * 16 + i * 8192, R, C); const int Rb = (R & ~31) + perm32(R & 31);
        voffA[i] = (unsigned)(R * K + C) * 2u; voffB[i] = (unsigned)(Rb * K + C) * 2u; }
    const size_t kstep = (size_t)(BK * 2);
    const size_t hstep = (size_t)HALF * K * 2;
    const size_t tstep = 2 * hstep;
    const unsigned ldsw = (unsigned)wid * 1024u;
    const int aoff = lds_byte(wr * 64 + fr, fq * 8), boff = lds_byte(wc * 32 + fr, fq * 8);
#define PG8_SA(b, h) (((b) * 2 + (h)) * HTB)
#define PG8_SB(b, h) ((4 + (b) * 2 + (h)) * HTB)
#define PG8_STAGE(bufoff, gbase, voff) do { _Pragma("unroll") for (int _i = 0; _i < 2; ++_i) \
        __builtin_amdgcn_global_load_lds((const unsigned*)((const char*)(gbase) + (voff)[_i]), (LAS unsigned*)(lds + (bufoff) + ldsw + _i * 8192), 16, 0, 0); } while (0)
#define PG8_LDA(dst, b, h) do { _Pragma("unroll") for (int m = 0; m < 4; ++m) _Pragma("unroll") for (int k = 0; k < 2; ++k) dst[m][k] = *(const LAS bf16x8*)(lds + PG8_SA(b, h) + aoff + m * 2048 + k * 1024); } while (0)
#define PG8_LDB(dst, b, h) do { _Pragma("unroll") for (int n = 0; n < 2; ++n) _Pragma("unroll") for (int k = 0; k < 2; ++k) dst[n][k] = *(const LAS bf16x8*)(lds + PG8_SB(b, h) + boff + n * 2048 + k * 1024); } while (0)
#define PG8_MMA(ai, bj, At, Bt) do { __builtin_amdgcn_s_setprio(1); _Pragma("unroll") for (int m = 0; m < 4; ++m) _Pragma("unroll") for (int n = 0; n < 2; ++n) _Pragma("unroll") for (int k = 0; k < 2; ++k) \
        acc[ai][bj][m][n] = __builtin_amdgcn_mfma_f32_16x16x32_bf16(Bt[n][k], At[m][k], acc[ai][bj][m][n], 0, 0, 0); __builtin_amdgcn_s_setprio(0); } while (0)
#define PG8_WAIT_V(n) asm volatile("s_waitcnt vmcnt(" #n ")" ::: "memory")
#define PG8_WAIT_L(n) asm volatile("s_waitcnt lgkmcnt(" #n ")" ::: "memory")
#define PG8_BAR __builtin_amdgcn_s_barrier()
#define PG8_SCHED __builtin_amdgcn_sched_barrier(0)
    Unit cur, nxt; int ui = 0;
    if (!S.next(0, cur)) return;
    f32x4 acc[2][2][4][2];
#pragma unroll
    for (int a = 0; a < 2; ++a)
#pragma unroll
        for (int b = 0; b < 2; ++b)
#pragma unroll
            for (int m = 0; m < 4; ++m)
#pragma unroll
                for (int n = 0; n < 2; ++n) acc[a][b][m][n] = (f32x4){0.f, 0.f, 0.f, 0.f};
    bf16x8 At[4][2], B0[2][2], B1[2][2];
    const char* cA = (const char*)g.A + (size_t)cur.pm * tstep; const char* cB = (const char*)g.Bt + (size_t)cur.pn * tstep;
    PG8_STAGE(PG8_SB(0, 0), cB, voffB); PG8_STAGE(PG8_SB(0, 1), cB + hstep, voffB); PG8_STAGE(PG8_SA(0, 0), cA, voffA); PG8_STAGE(PG8_SA(0, 1), cA + hstep, voffA);
    if (wr == 1) PG8_BAR;
    PG8_WAIT_V(2); PG8_BAR;
    PG8_STAGE(PG8_SB(1, 0), cB + kstep, voffB); PG8_STAGE(PG8_SA(1, 0), cA + kstep, voffA); PG8_STAGE(PG8_SB(1, 1), cB + hstep + kstep, voffB);
    PG8_WAIT_V(6); PG8_BAR;
    for (;;) {
        const bool has_next = S.next(ui + 1, nxt);
        const char* nA = has_next ? (const char*)g.A + (size_t)nxt.pm * tstep : cA; const char* nB = has_next ? (const char*)g.Bt + (size_t)nxt.pn * tstep : cB;
        for (int t = 0; t < nt; t += 2) {
            if constexpr (Epi::HAS_MID) { if (t == nt / 2) E.mid(acc, cur, wr, wc, fr, fq); }
            const bool last = (t == nt - 2);
            const char* a1 = cA + (size_t)(t + 1) * kstep;
            const char* a2 = last ? nA : cA + (size_t)(t + 2) * kstep; const char* b2 = last ? nB : cB + (size_t)(t + 2) * kstep;
            const char* a3 = a2 + kstep; const char* b3 = b2 + kstep;
            PG8_LDB(B0, 0, 0); PG8_LDB(B1, 0, 1); PG8_SCHED; PG8_LDA(At, 0, 0); PG8_STAGE(PG8_SA(1, 1), a1 + hstep, voffA);
            PG8_WAIT_V(8); PG8_WAIT_L(0); PG8_BAR; PG8_MMA(0, 0, At, B0); PG8_MMA(0, 1, At, B1); PG8_BAR; PG8_SCHED;
            PG8_LDA(At, 0, 1); PG8_STAGE(PG8_SB(0, 0), b2, voffB); PG8_STAGE(PG8_SB(0, 1), b2 + hstep, voffB); PG8_STAGE(PG8_SA(0, 0), a2, voffA);
            PG8_WAIT_V(8); PG8_WAIT_L(0); PG8_BAR; PG8_MMA(1, 0, At, B0); PG8_MMA(1, 1, At, B1); PG8_BAR; PG8_SCHED;
            PG8_LDB(B0, 1, 0); PG8_LDB(B1, 1, 1); PG8_SCHED; PG8_LDA(At, 1, 0); PG8_STAGE(PG8_SA(0, 1), a2 + hstep, voffA);
            PG8_WAIT_V(8); PG8_WAIT_L(0); PG8_BAR; PG8_MMA(0, 0, At, B0); PG8_MMA(0, 1, At, B1); PG8_BAR; PG8_SCHED;
            PG8_LDA(At, 1, 1); PG8_STAGE(PG8_SB(1, 0), b3, voffB); PG8_STAGE(PG8_SB(1, 1), b3 + hstep, voffB); PG8_STAGE(PG8_SA(1, 0), a3, voffA);
            PG8_WAIT_V(8); PG8_WAIT_L(0); PG8_BAR; PG8_MMA(1, 0, At, B0); PG8_MMA(1, 1, At, B1); PG8_BAR; PG8_SCHED;
        }
        if (wr == 0) PG8_BAR;
        E(acc, cur, wr, wc, fr, fq);
        if (!has_next) break;
#pragma unroll
        for (int a = 0; a < 2; ++a)
#pragma unroll
            for (int b = 0; b < 2; ++b)
#pragma unroll
                for (int m = 0; m < 4; ++m)
#pragma unroll
                    for (int n = 0; n < 2; ++n) acc[a][b][m][n] = (f32x4){0.f, 0.f, 0.f, 0.f};
        cur = nxt; cA = nA; cB = nB; ++ui;
        if (wr == 1) PG8_BAR;
    }
    PG8_WAIT_V(0);
    PG8_BAR;
#undef PG8_SA
#undef PG8_SB
#undef PG8_STAGE
#undef PG8_LDA
#undef PG8_LDB
#undef PG8_MMA
#undef PG8_WAIT_V
#undef PG8_WAIT_L
#undef PG8_BAR
#undef PG8_SCHED
}
}
using pg8::cvt_pk_bf16;

__device__ __forceinline__ float fast_sigmoid(float z) { return __builtin_amdgcn_rcpf(1.f + __builtin_amdgcn_exp2f(-z * L2E)); }
__device__ __forceinline__ float gelu_tanh(float x) { const float u = 0.7978845608028654f * (x + 0.044715f * x * x * x); return x * fast_sigmoid(2.f * u); }
__device__ __forceinline__ u32x4 pack8(f32x4 a, f32x4 b) { u32x4 w; w.x = cvt_pk_bf16(a[0], a[1]); w.y = cvt_pk_bf16(a[2], a[3]); w.z = cvt_pk_bf16(b[0], b[1]); w.w = cvt_pk_bf16(b[2], b[3]); return w; }
__device__ __forceinline__ float wave_sum(float v) {
#pragma unroll
    for (int o = 1; o < 64; o <<= 1) v += __shfl_xor(v, o);
    return v;
}
#define EPI_LOOP(...) _Pragma("unroll") for (int ai = 0; ai < 2; ++ai) _Pragma("unroll") for (int m = 0; m < 4; ++m) { const int row = u.pm * 256 + ai * 128 + wr * 64 + m * 16 + fr; \
    _Pragma("unroll") for (int bj = 0; bj < 2; ++bj) { const int tc = bj * 128 + wc * 32 + 8 * fq; f32x4 v0 = acc[ai][bj][m][0], v1 = acc[ai][bj][m][1]; __VA_ARGS__ } }

__device__ __forceinline__ void unpack_bf16x8(const u32x4 g, f32x4& g0, f32x4& g1) {
    g0[0] = __uint_as_float(g.x << 16); g0[1] = __uint_as_float(g.x & 0xffff0000u); g0[2] = __uint_as_float(g.y << 16); g0[3] = __uint_as_float(g.y & 0xffff0000u);
    g1[0] = __uint_as_float(g.z << 16); g1[1] = __uint_as_float(g.z & 0xffff0000u); g1[2] = __uint_as_float(g.w << 16); g1[3] = __uint_as_float(g.w & 0xffff0000u);
}
struct EpiIn {
    static constexpr bool PERM = true, HAS_MID = false;
    bf16_t *XR, *GATE, *Q, *K, *V, *G; float* out; const float* b_gate;
    __device__ __forceinline__ void operator()(const f32x4 (&acc)[2][2][4][2], const pg8::Unit& u, int wr, int wc, int fr, int fq) const {
        const int seg = u.pn >> 2, ct = (u.pn & 3) * 256;
        if (seg == 0) {
            EPI_LOOP({ const int col = ct + tc; *(u32x4*)(XR + (size_t)row * D + col) = pack8(v0, v1);
                       const int rr = row < MP ? row - (MP - 3) : ((row & 63) - 61);
                       if (rr >= 0) { float* o = row < MP ? out + O_CVP + (size_t)rr * D + col : out + O_CVS + ((size_t)((row - MP) >> 6) * 3 + rr) * D + col; *(f32x4*)o = v0; *(f32x4*)(o + 4) = v1; } })
        } else if (seg == 1) {
            EPI_LOOP({ const int col = ct + tc; _Pragma("unroll") for (int i = 0; i < 4; ++i) { v0[i] = gelu_tanh(v0[i]); v1[i] = gelu_tanh(v1[i]); }
                       *(u32x4*)(GATE + (size_t)row * D + col) = pack8(v0, v1); })
        } else if (seg == 2) {
            EPI_LOOP({ const int col = ct + tc; *(u32x4*)(Q + (size_t)row * D + col) = pack8(v0 * QSCALE, v1 * QSCALE); })
        } else if (seg == 3 || seg == 4) {
            bf16_t* B = seg == 3 ? K : V; const size_t op = seg == 3 ? O_KP : O_VP, os = seg == 3 ? O_KS : O_VS;
            EPI_LOOP({ const int col = ct + tc; *(u32x4*)(B + (size_t)row * D + col) = pack8(v0, v1);
                       float* o = row < MP ? out + op + (size_t)row * D + col : out + os + (size_t)(row - MP) * D + col; *(f32x4*)o = v0; *(f32x4*)(o + 4) = v1; })
        } else {
            const int gt = (u.pn - 20) * 256;
            EPI_LOOP({ const int col = gt + tc; const f32x4 b0 = *(const f32x4*)(b_gate + col), b1 = *(const f32x4*)(b_gate + col + 4);
                       _Pragma("unroll") for (int i = 0; i < 4; ++i) { v0[i] = fast_sigmoid(v0[i] + b0[i]); v1[i] = fast_sigmoid(v1[i] + b1[i]); }
                       *(u32x4*)(G + (size_t)row * 2048 + col) = pack8(v0, v1); })
        }
    }
};
struct EpiM1 {
    static constexpr bool PERM = true, HAS_MID = false;
    const bf16_t* G; float* T1;
    __device__ __forceinline__ void operator()(const f32x4 (&acc)[2][2][4][2], const pg8::Unit& u, int wr, int wc, int fr, int fq) const {
        EPI_LOOP({ const int col = u.pn * 256 + tc; const u32x4 g = *(const u32x4*)(G + (size_t)row * 2048 + col);
                   f32x4 g0, g1; g0[0] = __uint_as_float(g.x << 16); g0[1] = __uint_as_float(g.x & 0xffff0000u); g0[2] = __uint_as_float(g.y << 16); g0[3] = __uint_as_float(g.y & 0xffff0000u);
                   g1[0] = __uint_as_float(g.z << 16); g1[1] = __uint_as_float(g.z & 0xffff0000u); g1[2] = __uint_as_float(g.w << 16); g1[3] = __uint_as_float(g.w & 0xffff0000u);
                   float* o = T1 + (size_t)row * D + col; *(f32x4*)o = v0 * g0; *(f32x4*)(o + 4) = v1 * g1; })
    }
};
struct EpiM2 {
    static constexpr bool PERM = true, HAS_MID = false;
    const bf16_t* G; const float* T1; bf16_t* MIXED;
    __device__ __forceinline__ void operator()(const f32x4 (&acc)[2][2][4][2], const pg8::Unit& u, int wr, int wc, int fr, int fq) const {
        EPI_LOOP({ const int col = u.pn * 256 + tc; const u32x4 g = *(const u32x4*)(G + (size_t)row * 2048 + 1024 + col);
                   f32x4 g0, g1; g0[0] = __uint_as_float(g.x << 16); g0[1] = __uint_as_float(g.x & 0xffff0000u); g0[2] = __uint_as_float(g.y << 16); g0[3] = __uint_as_float(g.y & 0xffff0000u);
                   g1[0] = __uint_as_float(g.z << 16); g1[1] = __uint_as_float(g.z & 0xffff0000u); g1[2] = __uint_as_float(g.w << 16); g1[3] = __uint_as_float(g.w & 0xffff0000u);
                   const float* t = T1 + (size_t)row * D + col; const f32x4 t0 = *(const f32x4*)t, t1 = *(const f32x4*)(t + 4);
                   *(u32x4*)(MIXED + (size_t)row * D + col) = pack8(t0 + v0 * g0, t1 + v1 * g1); })
    }
};
struct EpiMerge {
    static constexpr bool PERM = true, HAS_MID = true;
    const bf16_t* G; bf16_t* MIXED;
    __device__ __forceinline__ void mid(f32x4 (&acc)[2][2][4][2], const pg8::Unit& u, int wr, int wc, int fr, int fq) const {
#pragma unroll
        for (int ai = 0; ai < 2; ++ai)
#pragma unroll
            for (int m = 0; m < 4; ++m) { const int row = u.pm * 256 + ai * 128 + wr * 64 + m * 16 + fr;
#pragma unroll
                for (int bj = 0; bj < 2; ++bj) { const int col = u.pn * 256 + bj * 128 + wc * 32 + 8 * fq; const bf16_t* gp = G + (size_t)row * 2048 + col;
                    f32x4 l0, l1, a0, a1; unpack_bf16x8(*(const u32x4*)gp, l0, l1); unpack_bf16x8(*(const u32x4*)(gp + 1024), a0, a1);
#pragma unroll
                    for (int i = 0; i < 4; ++i) { acc[ai][bj][m][0][i] *= l0[i] * __builtin_amdgcn_rcpf(fmaxf(a0[i], 1e-30f)); acc[ai][bj][m][1][i] *= l1[i] * __builtin_amdgcn_rcpf(fmaxf(a1[i], 1e-30f)); } } }
    }
    __device__ __forceinline__ void operator()(const f32x4 (&acc)[2][2][4][2], const pg8::Unit& u, int wr, int wc, int fr, int fq) const {
        EPI_LOOP({ const int col = u.pn * 256 + tc; f32x4 a0, a1; unpack_bf16x8(*(const u32x4*)(G + (size_t)row * 2048 + 1024 + col), a0, a1);
                   _Pragma("unroll") for (int i = 0; i < 4; ++i) { a0[i] = fmaxf(a0[i], 1e-30f); a1[i] = fmaxf(a1[i], 1e-30f); }
                   *(u32x4*)(MIXED + (size_t)row * D + col) = pack8(v0 * a0, v1 * a1); })
    }
};
struct EpiOut {
    static constexpr bool PERM = true, HAS_MID = false;
    const float *xp, *xs; bf16_t* X2B; float* rss;
    __device__ __forceinline__ void operator()(const f32x4 (&acc)[2][2][4][2], const pg8::Unit& u, int wr, int wc, int fr, int fq) const {
#pragma unroll
        for (int ai = 0; ai < 2; ++ai)
#pragma unroll
            for (int m = 0; m < 4; ++m) { const int row = u.pm * 256 + ai * 128 + wr * 64 + m * 16 + fr; float ss = 0.f;
                const float* xrow = row < MP ? xp + (size_t)row * D : xs + (size_t)(row - MP) * D;
#pragma unroll
                for (int bj = 0; bj < 2; ++bj) { const int col = u.pn * 256 + bj * 128 + wc * 32 + 8 * fq;
                    f32x4 v0 = acc[ai][bj][m][0] + *(const f32x4*)(xrow + col), v1 = acc[ai][bj][m][1] + *(const f32x4*)(xrow + col + 4);
                    ss += (v0[0] * v0[0] + v0[1] * v0[1]) + (v0[2] * v0[2] + v0[3] * v0[3]) + (v1[0] * v1[0] + v1[1] * v1[1]) + (v1[2] * v1[2] + v1[3] * v1[3]);
                    *(u32x4*)(X2B + (size_t)row * D + col) = pack8(v0, v1); }
                ss += __shfl_xor(ss, 16); ss += __shfl_xor(ss, 32);
                if (fq == 0) atomicAdd(rss + row, ss); }
    }
};
struct EpiFfnIn {
    static constexpr bool PERM = true, HAS_MID = false;
    const float* rss; bf16_t* HFF;
    __device__ __forceinline__ void operator()(const f32x4 (&acc)[2][2][4][2], const pg8::Unit& u, int wr, int wc, int fr, int fq) const {
#pragma unroll
        for (int ai = 0; ai < 2; ++ai)
#pragma unroll
            for (int m = 0; m < 4; ++m) { const int row = u.pm * 256 + ai * 128 + wr * 64 + m * 16 + fr;
                const float rstd = __builtin_amdgcn_rsqf(rss[row] * (1.f / D) + EPS);
                f32x4 h0, h1;
#pragma unroll
                for (int i = 0; i < 4; ++i) { const float g0 = acc[ai][0][m][0][i] * rstd, u0 = acc[ai][1][m][0][i] * rstd, g1 = acc[ai][0][m][1][i] * rstd, u1 = acc[ai][1][m][1][i] * rstd;
                    h0[i] = g0 * fast_sigmoid(g0) * u0; h1[i] = g1 * fast_sigmoid(g1) * u1; }
                *(u32x4*)(HFF + (size_t)row * DFF + u.pn * 128 + wc * 32 + 8 * fq) = pack8(h0, h1); }
    }
};
struct EpiFfnOut {
    static constexpr bool PERM = true, HAS_MID = false;
    const bf16_t* X2B; bf16_t* X3B; float* rss;
    __device__ __forceinline__ void operator()(const f32x4 (&acc)[2][2][4][2], const pg8::Unit& u, int wr, int wc, int fr, int fq) const {
#pragma unroll
        for (int ai = 0; ai < 2; ++ai)
#pragma unroll
            for (int m = 0; m < 4; ++m) { const int row = u.pm * 256 + ai * 128 + wr * 64 + m * 16 + fr; float ss = 0.f;
#pragma unroll
                for (int bj = 0; bj < 2; ++bj) { const int col = u.pn * 256 + bj * 128 + wc * 32 + 8 * fq;
                    f32x4 x0, x1; unpack_bf16x8(*(const u32x4*)(X2B + (size_t)row * D + col), x0, x1);
                    const f32x4 v0 = acc[ai][bj][m][0] + x0, v1 = acc[ai][bj][m][1] + x1;
                    ss += (v0[0] * v0[0] + v0[1] * v0[1]) + (v0[2] * v0[2] + v0[3] * v0[3]) + (v1[0] * v1[0] + v1[1] * v1[1]) + (v1[2] * v1[2] + v1[3] * v1[3]);
                    *(u32x4*)(X3B + (size_t)row * D + col) = pack8(v0, v1); }
                ss += __shfl_xor(ss, 16); ss += __shfl_xor(ss, 32);
                if (fq == 0) atomicAdd(rss + row, ss); }
    }
};

__device__ __forceinline__ void p0_transpose_item(const float* W, int ldw, int k0, int n0, bf16_t* WT, int ldt, int dst_row0, LAS float* scr, int lane, const float* kscale = nullptr) {
#pragma unroll
    for (int i = 0; i < 32; ++i) { const int kk = 2 * i + (lane >> 5); scr[kk * 33 + (lane & 31)] = W[(size_t)(k0 + kk) * ldw + n0 + (lane & 31)] * (kscale ? kscale[k0 + kk] : 1.f); }
    asm volatile("s_waitcnt lgkmcnt(0)" ::: "memory");
    const int c = lane & 7;
#pragma unroll
    for (int j = 0; j < 4; ++j) { const int n = (lane >> 3) + 8 * j; const LAS float* s = scr + (8 * c) * 33 + n;
        u32x4 o; o.x = cvt_pk_bf16(s[0 * 33], s[1 * 33]); o.y = cvt_pk_bf16(s[2 * 33], s[3 * 33]); o.z = cvt_pk_bf16(s[4 * 33], s[5 * 33]); o.w = cvt_pk_bf16(s[6 * 33], s[7 * 33]);
        *(u32x4*)(WT + (size_t)(dst_row0 + n) * ldt + k0 + 8 * c) = o; }
    asm volatile("s_waitcnt lgkmcnt(0)" ::: "memory");
}
constexpr int P0_SCR = 0  , P0_WFL = 69632  , P0_LF = P0_WFL + 65536  , P0_SEG = P0_LF + 4096  ;
__device__ __forceinline__ void p0_phase(const Args& a, LAS unsigned char* lds, int tid, int lane, int wave) {
    unsigned char* ws = a.ws;
    { float* r2 = (float*)(ws + WS_RSS2); float* r3 = (float*)(ws + WS_RSS3);
      for (int i = blockIdx.x * 512 + tid; i < M; i += gridDim.x * 512) { r2[i] = 0.f; r3[i] = 0.f; }
      if (blockIdx.x == 0 && tid == 0) ((unsigned*)(ws + WS_CTL))[0] = 0u; }
    LAS float* wfl = (LAS float*)(lds + P0_WFL);
    { const float* w_in = a.in[8];
      for (int i = tid; i < 4096; i += 512) { const int col = i >> 2, q = i & 3; *(LAS f32x4*)(wfl + col * 16 + 4 * q) = *(const f32x4*)(w_in + (size_t)col * DIN + NIN + 4 * q); } }
    __syncthreads();
    LAS float* lf = (LAS float*)(lds + P0_LF);
    LAS float* sg = (LAS float*)(lds + P0_SEG);
    const float* gmix = a.in[7]; const float* bfg = a.in[9];
    float gm[16];
#pragma unroll
    for (int j = 0; j < 16; ++j) gm[j] = gmix[lane + 64 * j];
    bf16_t* XN = (bf16_t*)(ws + WS_XN);
    for (int c = blockIdx.x; c < 784; c += gridDim.x) {
        if (c < 272) {
            for (int i4 = 0; i4 < 2; ++i4) {
                float xa[4][16];
#pragma unroll
                for (int u = 0; u < 4; ++u) { const int row = c * 64 + wave * 8 + i4 * 4 + u; const float* xrow = row < MP ? a.in[0] + (size_t)row * D : a.in[1] + (size_t)(row - MP) * D;
#pragma unroll
                    for (int j = 0; j < 16; ++j) xa[u][j] = xrow[lane + 64 * j]; }
#pragma unroll
                for (int u = 0; u < 4; ++u) {
                const int rl = wave * 8 + i4 * 4 + u, row = c * 64 + rl;
                float ss = 0.f;
#pragma unroll
                for (int j = 0; j < 16; ++j) ss += xa[u][j] * xa[u][j];
                const float rstd = 1.0f / sqrtf(wave_sum(ss) * (1.f / D) + EPS);
                float f[16];
#pragma unroll
                for (int h = 0; h < 16; ++h) f[h] = 0.f;
#pragma unroll
                for (int j = 0; j < 16; ++j) { const float xn = xa[u][j] * rstd * gm[j];
                    XN[(size_t)row * D + lane + 64 * j] = (bf16_t)(cvt_pk_bf16(xn, 0.f) & 0xffffu);
                    const LAS f32x4* wp = (const LAS f32x4*)(wfl + (lane + 64 * j) * 16);
#pragma unroll
                    for (int q = 0; q < 4; ++q) { const f32x4 w = wp[q]; f[4 * q + 0] += xn * w[0]; f[4 * q + 1] += xn * w[1]; f[4 * q + 2] += xn * w[2]; f[4 * q + 3] += xn * w[3]; } }
                { const bool b5 = lane & 32;
#pragma unroll
                  for (int k = 0; k < 8; ++k) { const float send = b5 ? f[k] : f[k + 8], keep = b5 ? f[k + 8] : f[k]; f[k] = keep + __shfl_xor(send, 32); }
                  const bool b4 = lane & 16;
#pragma unroll
                  for (int k = 0; k < 4; ++k) { const float send = b4 ? f[k] : f[k + 4], keep = b4 ? f[k + 4] : f[k]; f[k] = keep + __shfl_xor(send, 16); }
                  const bool b3 = lane & 8;
#pragma unroll
                  for (int k = 0; k < 2; ++k) { const float send = b3 ? f[k] : f[k + 2], keep = b3 ? f[k + 2] : f[k]; f[k] = keep + __shfl_xor(send, 8); }
                  const bool b2 = lane & 4;
                  { const float send = b2 ? f[0] : f[1], keep = b2 ? f[1] : f[0]; f[0] = keep + __shfl_xor(send, 4); }
                  f[0] += __shfl_xor(f[0], 2); f[0] += __shfl_xor(f[0], 1); }
                if ((lane & 3) == 0) { const int hh = ((lane >> 5) & 1) * 8 + ((lane >> 4) & 1) * 4 + ((lane >> 3) & 1) * 2 + ((lane >> 2) & 1);
                    const float z = f[0] + bfg[hh]; const float lg = fminf(z, 0.f) - log1pf(expf(-fabsf(z)));
                    lf[rl * 16 + hh] = lg;
                    if (row < MP) a.out[O_LFP + (size_t)row * NH + hh] = lg; else a.out[O_LFS + (size_t)(row - MP) * NH + hh] = lg; }
                }
            }
        } else {
            const int cc = c - 272; const float* src = a.in[4] + (size_t)cc * 1024;
            lf[tid] = src[tid]; lf[tid + 512] = src[tid + 512];
        }
        __syncthreads();
        float s0 = 0.f, s1 = 0.f, s2 = 0.f, s3 = 0.f; const int hh = tid & 15, seg = tid >> 4;
        if (tid < 256) { s0 = lf[(seg * 4 + 0) * 16 + hh]; s1 = s0 + lf[(seg * 4 + 1) * 16 + hh]; s2 = s1 + lf[(seg * 4 + 2) * 16 + hh]; s3 = s2 + lf[(seg * 4 + 3) * 16 + hh]; sg[seg * 16 + hh] = s3; }
        __syncthreads();
        if (tid < 256) { float pre = 0.f;
#pragma unroll
            for (int s = 0; s < 16; ++s) { const float v = sg[s * 16 + hh]; pre += (s < seg) ? v : 0.f; }
            float* dst;
            if (c < 272) dst = (float*)(ws + WS_CLT) + (size_t)hh * M + c * 64 + seg * 4;
            else { const int cc = c - 272; dst = (float*)(ws + WS_CLTC) + ((size_t)((cc >> 5) * 16 + hh) * PAST) + (cc & 31) * 64 + seg * 4; }
            *(f32x4*)dst = (f32x4){pre + s0, pre + s1, pre + s2, pre + s3};
            if (seg == 15) { if (c < 272) ((float*)(ws + WS_CSP))[c * 16 + hh] = pre + s3; else ((float*)(ws + WS_CSC))[(c - 272) * 16 + hh] = pre + s3; } }
        __syncthreads();
    }
    LAS float* scr = (LAS float*)(lds + P0_SCR + wave * 8448);
    const int gw = gridDim.x > 32 ? ((int)blockIdx.x - 16) * 8 + wave : (int)blockIdx.x * 8 + wave, NGW = gridDim.x > 32 ? (gridDim.x - 16) * 8 : gridDim.x * 8;
    constexpr int I_IN = 16 * (NIN / 32), I_SQ = 16 * 32, I_FFI = 16 * (2 * DFF / 32), I_FFO = (DFF / 64) * 32;
    constexpr int NITEMS = I_IN + 3 * I_SQ + I_FFI + I_FFO;
    for (int it = gw < 0 ? NITEMS : gw; it < NITEMS; it += NGW) {
        int r = it;
        if (r < I_IN) { const int nb = NIN / 32, kb = r / nb, n0 = (r % nb) * 32; p0_transpose_item(a.in[8], DIN, kb * 64, n0, (bf16_t*)(ws + WS_WIN), D, n0, scr, lane); continue; } r -= I_IN;
        if (r < I_SQ) { const int kb = r / 32, n0 = (r % 32) * 32; p0_transpose_item(a.in[18], D, kb * 64, n0, (bf16_t*)(ws + WS_WCAT), 2 * D, n0, scr, lane); continue; } r -= I_SQ;
        if (r < I_SQ) { const int kb = r / 32, n0 = (r % 32) * 32; p0_transpose_item(a.in[19], D, kb * 64, n0, (bf16_t*)(ws + WS_WCAT) + D, 2 * D, n0, scr, lane); continue; } r -= I_SQ;
        if (r < I_SQ) { const int kb = r / 32, n0 = (r % 32) * 32; p0_transpose_item(a.in[20], D, kb * 64, n0, (bf16_t*)(ws + WS_WOUT), D, n0, scr, lane); continue; } r -= I_SQ;
        if (r < I_FFI) { const int nb = 2 * DFF / 32, kb = r / nb, n0 = (r % nb) * 32; const int nn = n0 < DFF ? n0 : n0 - DFF; const int drow = (nn >> 7) * 256 + (n0 < DFF ? 0 : 128) + (nn & 127);
            p0_transpose_item(a.in[22], 2 * DFF, kb * 64, n0, (bf16_t*)(ws + WS_WFFI), D, drow, scr, lane, a.in[21]); continue; } r -= I_FFI;
        { const int kb = r / 32, n0 = (r % 32) * 32; p0_transpose_item(a.in[23], D, kb * 64, n0, (bf16_t*)(ws + WS_WFFO), DFF, n0, scr, lane); }
    }
}

__device__ __forceinline__ void prefix_task(const Args& a, LAS unsigned char* lds, int tid) {
    unsigned char* ws = a.ws;
    LAS float* sp = (LAS float*)lds;
    LAS float* sc = (LAS float*)(lds + 32768);
    const float* csp = (const float*)(ws + WS_CSP); const float* csc = (const float*)(ws + WS_CSC);
    for (int i = tid; i < 272 * 16; i += 512) sp[i] = csp[i];
    for (int i = tid; i < 512 * 16; i += 512) sc[i] = csc[i];
    __syncthreads();
    if (tid < 16) { float run = 0.f; float* o = (float*)(ws + WS_PFXP) + tid * 256;
        for (int c = 0; c < 256; ++c) { o[c] = run; run += sp[c * 16 + tid]; } }
    else if (tid >= 64 && tid < 64 + 256) { const int bh = tid - 64, b = bh >> 4, h = bh & 15; float run = 0.f; float* o = (float*)(ws + WS_PFXC) + bh * 32;
        for (int c = 0; c < 32; ++c) { o[c] = run; run += sc[(b * 32 + c) * 16 + h]; }
        ((float*)(ws + WS_PFXS))[bh] = run; }
    __syncthreads();
}

constexpr int AT_K = 0, AT_KB = 64 * 144, AT_V = 2 * AT_KB, AT_VB = 64 * 160, AT_CK = AT_V + 2 * AT_VB, AT_END = AT_CK + 512;
__device__ __forceinline__ int crow(int r, int hi) { return (r & 3) + 8 * (r >> 2) + 4 * hi; }
__device__ __forceinline__ void attn_tile(const LAS unsigned char* Kt, const LAS unsigned char* Vt, const LAS f32x4* ck, const bf16x8 (&qr)[4], const float cq2, const int kp0, const int qpos, const int qfirst,
                                          const int lane, const int r32, const int hi, float& m_run, float& l_run, float& cqm, f32x16& o0, f32x16& o1) {
            f32x16 p0, p1;
            const bool first = (m_run == -INFINITY);
            const float cbase = first ? cq2 : cqm;
#pragma unroll
            for (int g = 0; g < 4; ++g) { const f32x4 c0 = ck[2 * g + hi], c1 = ck[8 + 2 * g + hi];
#pragma unroll
                for (int i = 0; i < 4; ++i) { p0[4 * g + i] = cbase - c0[i]; p1[4 * g + i] = cbase - c1[i]; } }
#pragma unroll
            for (int d0 = 0; d0 < 4; ++d0) {
                const bf16x8 k0 = *(const LAS bf16x8*)(Kt + r32 * 144 + d0 * 32 + hi * 16), k1 = *(const LAS bf16x8*)(Kt + (32 + r32) * 144 + d0 * 32 + hi * 16);
                p0 = __builtin_amdgcn_mfma_f32_32x32x16_bf16(k0, qr[d0], p0, 0, 0, 0); p1 = __builtin_amdgcn_mfma_f32_32x32x16_bf16(k1, qr[d0], p1, 0, 0, 0); }
            if (kp0 + 63 > qfirst) {
#pragma unroll
                for (int r = 0; r < 16; ++r) { const int kk = kp0 + crow(r, hi); if (kk > qpos) p0[r] = -INFINITY; if (kk + 32 > qpos) p1[r] = -INFINITY; } }
            float rm = fmaxf(p0[0], p1[0]);
#pragma unroll
            for (int r = 1; r < 16; ++r) rm = fmaxf(rm, fmaxf(p0[r], p1[r]));
            rm = fmaxf(rm, __shfl_xor(rm, 32));
            if (first) { m_run = rm; cqm = cq2 - rm;
#pragma unroll
                for (int r = 0; r < 16; ++r) { p0[r] -= rm; p1[r] -= rm; } }
            else if (__any(rm > 8.f)) { const float dl = fmaxf(rm, 0.f), alpha = __builtin_amdgcn_exp2f(-dl); m_run += dl; cqm -= dl; l_run *= alpha;
#pragma unroll
                for (int r = 0; r < 16; ++r) { p0[r] -= dl; p1[r] -= dl; o0[r] *= alpha; o1[r] *= alpha; } }
            float ps = 0.f;
#pragma unroll
            for (int r = 0; r < 16; ++r) { p0[r] = __builtin_amdgcn_exp2f(p0[r]); p1[r] = __builtin_amdgcn_exp2f(p1[r]); ps += p0[r] + p1[r]; }
            l_run += ps;
            bf16x8 pa[4];
            { u32x4 w;
              w.x = cvt_pk_bf16(p0[0], p0[1]); w.y = cvt_pk_bf16(p0[2], p0[3]); w.z = cvt_pk_bf16(p0[4], p0[5]); w.w = cvt_pk_bf16(p0[6], p0[7]); pa[0] = __builtin_bit_cast(bf16x8, w);
              w.x = cvt_pk_bf16(p0[8], p0[9]); w.y = cvt_pk_bf16(p0[10], p0[11]); w.z = cvt_pk_bf16(p0[12], p0[13]); w.w = cvt_pk_bf16(p0[14], p0[15]); pa[1] = __builtin_bit_cast(bf16x8, w);
              w.x = cvt_pk_bf16(p1[0], p1[1]); w.y = cvt_pk_bf16(p1[2], p1[3]); w.z = cvt_pk_bf16(p1[4], p1[5]); w.w = cvt_pk_bf16(p1[6], p1[7]); pa[2] = __builtin_bit_cast(bf16x8, w);
              w.x = cvt_pk_bf16(p1[8], p1[9]); w.y = cvt_pk_bf16(p1[10], p1[11]); w.z = cvt_pk_bf16(p1[12], p1[13]); w.w = cvt_pk_bf16(p1[14], p1[15]); pa[3] = __builtin_bit_cast(bf16x8, w); }
            const LAS unsigned char* vbase = Vt + (4 * hi + ((lane & 15) >> 2)) * 160 + ((lane >> 4) & 1) * 32 + (lane & 3) * 8;
#pragma unroll
            for (int kk = 0; kk < 4; ++kk) {
#pragma unroll
                for (int dh = 0; dh < 2; ++dh) {
                    const v4i16_t lo = __builtin_amdgcn_ds_read_tr16_b64_v4i16((LAS v4i16_t*)(vbase + kk * 16 * 160 + dh * 64));
                    const v4i16_t hv = __builtin_amdgcn_ds_read_tr16_b64_v4i16((LAS v4i16_t*)(vbase + kk * 16 * 160 + 8 * 160 + dh * 64));
                    const bf16x8 vf = (bf16x8){lo[0], lo[1], lo[2], lo[3], hv[0], hv[1], hv[2], hv[3]};
                    if (dh == 0) o0 = __builtin_amdgcn_mfma_f32_32x32x16_bf16(vf, pa[kk], o0, 0, 0, 0); else o1 = __builtin_amdgcn_mfma_f32_32x32x16_bf16(vf, pa[kk], o1, 0, 0, 0); } }
}

__device__ __forceinline__ void attn_unit(const Args& a, LAS unsigned char* lds, const int mode, const int h, const int qb, const int tid_in, const int lane_in, const int wave) {
    int tid = tid_in; asm volatile("" : "+v"(tid)); const int lane = tid & 63;
    unsigned char* ws = a.ws;
    const bf16_t* Qb = (const bf16_t*)(ws + WS_Q); const bf16_t* Kb = (const bf16_t*)(ws + WS_K); const bf16_t* Vb = (const bf16_t*)(ws + WS_V);
    const float* CLT = (const float*)(ws + WS_CLT) + (size_t)h * M;
    const int r32 = lane & 31, hi = lane >> 5;
    const int NT = mode == 0 ? 4 * qb + 4 : 33;
    const int nqw = mode == 0 ? 8 : 2;
    const bool active = wave < nqw;
    const int qrow = mode == 0 ? qb * 256 + wave * 32 + r32 : MP + qb * 64 + (wave & 1) * 32 + r32;
    const int qpos = mode == 0 ? qrow : PAST + (wave & 1) * 32 + r32;
    const int qfirst = qpos - r32;
    float cq2; bf16x8 qr[4];
    { const float pfx = mode == 0 ? ((const float*)(ws + WS_PFXP))[h * 256 + (qrow >> 6)] : ((const float*)(ws + WS_PFXS))[qb * 16 + h];
      cq2 = (pfx + CLT[qrow]) * L2E;
#pragma unroll
      for (int d0 = 0; d0 < 4; ++d0) qr[d0] = *(const bf16x8*)(Qb + (size_t)qrow * D + h * HD + d0 * 16 + hi * 8); }
    const int sr = tid >> 3, sc8 = tid & 7;
    f32x4 kst[2], vst[2]; float ckst = 0.f;
    auto tile_load = [&](int j) {
        if (mode == 1 && j < 32) {
            const size_t off = (((size_t)(qb * PAST + j * 64 + sr)) * NH + h) * HD + sc8 * 8;
            const float* kp = a.in[2] + off; const float* vp = a.in[3] + off;
            kst[0] = *(const f32x4*)kp; kst[1] = *(const f32x4*)(kp + 4); vst[0] = *(const f32x4*)vp; vst[1] = *(const f32x4*)(vp + 4);
            if (tid < 64) ckst = (((const float*)(ws + WS_PFXC))[(qb * 16 + h) * 32 + j] + ((const float*)(ws + WS_CLTC))[(size_t)(qb * 16 + h) * PAST + j * 64 + tid]) * L2E;
        } else {
            const int krow = mode == 0 ? j * 64 : MP + qb * 64;
            const size_t off = (size_t)(krow + sr) * D + h * HD + sc8 * 8;
            kst[0] = *(const f32x4*)(Kb + off); vst[0] = *(const f32x4*)(Vb + off);
            if (tid < 64) { const float pfx = mode == 0 ? ((const float*)(ws + WS_PFXP))[h * 256 + j] : ((const float*)(ws + WS_PFXS))[qb * 16 + h];
                ckst = (pfx + CLT[krow + tid]) * L2E; }
        }
    };
    auto tile_write = [&](int j, int buf) {
        u32x4 kw, vw;
        if (mode == 1 && j < 32) { kw = pack8(kst[0], kst[1]); vw = pack8(vst[0], vst[1]); }
        else { kw = __builtin_bit_cast(u32x4, kst[0]); vw = __builtin_bit_cast(u32x4, vst[0]); }
        *(LAS u32x4*)(lds + AT_K + buf * AT_KB + sr * 144 + sc8 * 16) = kw;
        *(LAS u32x4*)(lds + AT_V + buf * AT_VB + sr * 160 + sc8 * 16) = vw;
        if (tid < 64) *(LAS float*)(lds + AT_CK + buf * 256 + tid * 4) = ckst;
    };
    float m_run = -INFINITY, l_run = 0.f, cqm = 0.f; f32x16 o0 = {}, o1 = {};
    int jstart = 0;
    if (mode == 0 && qb > 0) {
        float dsc = 0.f;
#pragma unroll
        for (int d0 = 0; d0 < 4; ++d0) { const u32x4 kw = *(const u32x4*)(Kb + (size_t)qrow * D + h * HD + d0 * 16 + hi * 8); const u32x4 qw = __builtin_bit_cast(u32x4, qr[d0]);
            const unsigned kk[4] = {kw.x, kw.y, kw.z, kw.w}; const unsigned qq[4] = {qw.x, qw.y, qw.z, qw.w};
#pragma unroll
            for (int e = 0; e < 4; ++e) dsc += __uint_as_float(kk[e] << 16) * __uint_as_float(qq[e] << 16) + __uint_as_float(kk[e] & 0xffff0000u) * __uint_as_float(qq[e] & 0xffff0000u); }
        dsc += __shfl_xor(dsc, 32);
#pragma unroll
        for (int o = 1; o < 32; o <<= 1) dsc = fminf(dsc, __shfl_xor(dsc, o));
        float qsq = 0.f;
#pragma unroll
        for (int d0 = 0; d0 < 4; ++d0) { const u32x4 qw = __builtin_bit_cast(u32x4, qr[d0]); const unsigned qq[4] = {qw.x, qw.y, qw.z, qw.w};
#pragma unroll
            for (int e = 0; e < 4; ++e) { const float lo = __uint_as_float(qq[e] << 16), hi_ = __uint_as_float(qq[e] & 0xffff0000u); qsq += lo * lo + hi_ * hi_; } }
        qsq += __shfl_xor(qsq, 32);
#pragma unroll
        for (int o = 1; o < 32; o <<= 1) qsq = fmaxf(qsq, __shfl_xor(qsq, o));
        LAS float* red = (LAS float*)(lds + AT_END);
        if (lane == 0) { red[wave] = dsc; red[8 + wave] = qsq; }
        __syncthreads();
        float dmin = red[0], qn = red[8];
#pragma unroll
        for (int w = 1; w < 8; ++w) { dmin = fminf(dmin, red[w]); qn = fmaxf(qn, red[8 + w]); }
        const float* N2 = (const float*)(ws + WS_N2); const float* PF = (const float*)(ws + WS_PFXP) + h * 256;
        const float cq0 = (PF[qb * 4] + CLT[qb * 256]) * L2E, base = cq0 - dmin + 0.05f + 30.f;
        int cnt = 0; bool open = true;
#pragma unroll
        for (int i = 0; i < 4; ++i) { const int j = lane + 64 * i; bool sk = false;
            if (j < 4 * qb) sk = (base - PF[j + 1] * L2E + sqrtf(qn * N2[j * 32 + 16 + h]) * 1.01f) < 0.f;
            const unsigned long long m = __ballot(sk); const bool full = (m == ~0ull);
            if (open) cnt += full ? 64 : __builtin_ctzll(~m);
            open = open && full; }
        jstart = __builtin_amdgcn_readfirstlane(cnt);
    }
    tile_load(jstart); tile_write(jstart, 0); __syncthreads();
    for (int j = jstart; j < NT; ++j) {
        const int buf = (j - jstart) & 1;
        if (j + 1 < NT) tile_load(j + 1);
        const int kp0 = j * 64;
        if (active && kp0 <= qfirst + 31) {
            attn_tile(lds + AT_K + buf * AT_KB, lds + AT_V + buf * AT_VB, (const LAS f32x4*)(lds + AT_CK + buf * 256), qr, cq2, kp0, qpos, qfirst, lane, r32, hi, m_run, l_run, cqm, o0, o1);
        }
        if (j + 1 < NT) tile_write(j + 1, buf ^ 1);
        __syncthreads();
    }
    if (active) {
        const float lt = l_run + __shfl_xor(l_run, 32); const float rl = 1.0f / lt;
        bf16_t* Y = (bf16_t*)(ws + WS_YCAT) + (size_t)qrow * (2 * D) + D + h * HD;
#pragma unroll
        for (int g = 0; g < 4; ++g) {
            u32x2 w0, w1; w0.x = cvt_pk_bf16(o0[4 * g] * rl, o0[4 * g + 1] * rl); w0.y = cvt_pk_bf16(o0[4 * g + 2] * rl, o0[4 * g + 3] * rl);
            w1.x = cvt_pk_bf16(o1[4 * g] * rl, o1[4 * g + 1] * rl); w1.y = cvt_pk_bf16(o1[4 * g + 2] * rl, o1[4 * g + 3] * rl);
            *(u32x2*)(Y + 8 * g + 4 * hi) = w0; *(u32x2*)(Y + 32 + 8 * g + 4 * hi) = w1; }
    }
}

constexpr int AS_K = 0, AS_V = 2 * AT_KB, AS_CK = AS_V + 2 * AT_VB, AS_END = AS_CK + 2 * 256, AS_CMB = 34 * 64 * 4;
__device__ __forceinline__ void attn_sample_unit(const Args& a, LAS unsigned char* lds, const int h, const int b, const int tid_in, const int lane_in, const int wave) {
    int tid = tid_in; asm volatile("" : "+v"(tid)); const int lane = tid & 63;
    unsigned char* ws = a.ws;
    const bf16_t* Qb = (const bf16_t*)(ws + WS_Q); const bf16_t* Kb = (const bf16_t*)(ws + WS_K); const bf16_t* Vb = (const bf16_t*)(ws + WS_V);
    const float* CLT = (const float*)(ws + WS_CLT) + (size_t)h * M;
    const int r32 = lane & 31, hi = lane >> 5, qh = wave & 1, ks = wave >> 1;
    const int qrow = MP + b * 64 + qh * 32 + r32, qpos = PAST + qh * 32 + r32, qfirst = qpos - r32;
    const float pfs = ((const float*)(ws + WS_PFXS))[b * 16 + h];
    const float cq2 = (pfs + CLT[qrow]) * L2E;
    bf16x8 qr[4];
#pragma unroll
    for (int d0 = 0; d0 < 4; ++d0) qr[d0] = *(const bf16x8*)(Qb + (size_t)qrow * D + h * HD + d0 * 16 + hi * 8);
    const int sr = tid >> 3, sc8 = tid & 7;
    f32x4 kst[2][2], vst[2][2]; float ckst = 0.f;
    const float* pfc = (const float*)(ws + WS_PFXC) + (b * 16 + h) * 32; const float* cltc = (const float*)(ws + WS_CLTC) + (size_t)(b * 16 + h) * PAST;
    auto load2 = [&](int i) {
#pragma unroll
        for (int t = 0; t < 2; ++t) { const int j = 2 * i + t;
            if (j < 32) { const size_t off = (((size_t)(b * PAST + j * 64 + sr)) * NH + h) * HD + sc8 * 8; const float* kp = a.in[2] + off; const float* vp = a.in[3] + off;
                kst[t][0] = *(const f32x4*)kp; kst[t][1] = *(const f32x4*)(kp + 4); vst[t][0] = *(const f32x4*)vp; vst[t][1] = *(const f32x4*)(vp + 4); }
            else if (j == 32) { const size_t off = (size_t)(MP + b * 64 + sr) * D + h * HD + sc8 * 8; kst[t][0] = *(const f32x4*)(Kb + off); vst[t][0] = *(const f32x4*)(Vb + off); } }
        if (tid < 128) { const int j = 2 * i + (tid >> 6); ckst = j < 32 ? (pfc[j] + cltc[j * 64 + (tid & 63)]) * L2E : (pfs + CLT[MP + b * 64 + (tid & 63)]) * L2E; }
    };
    auto write2 = [&](int i) {
#pragma unroll
        for (int t = 0; t < 2; ++t) { const int j = 2 * i + t; u32x4 kw, vw;
            if (j < 32) { kw = pack8(kst[t][0], kst[t][1]); vw = pack8(vst[t][0], vst[t][1]); } else { kw = __builtin_bit_cast(u32x4, kst[t][0]); vw = __builtin_bit_cast(u32x4, vst[t][0]); }
            *(LAS u32x4*)(lds + AS_K + t * AT_KB + sr * 144 + sc8 * 16) = kw; *(LAS u32x4*)(lds + AS_V + t * AT_VB + sr * 160 + sc8 * 16) = vw; }
        if (tid < 128) *(LAS float*)(lds + AS_CK + tid * 4) = ckst;
    };
    float m_run = -INFINITY, l_run = 0.f, cqm = 0.f; f32x16 o0 = {}, o1 = {};
    load2(0); write2(0); __syncthreads();
    for (int i = 0; i < 17; ++i) {
        if (i + 1 < 17) load2(i + 1);
        if (ks < 2 && 2 * i + ks < 33) attn_tile(lds + AS_K + ks * AT_KB, lds + AS_V + ks * AT_VB, (const LAS f32x4*)(lds + AS_CK + ks * 256), qr, cq2, (2 * i + ks) * 64, qpos, qfirst, lane, r32, hi, m_run, l_run, cqm, o0, o1);
        __syncthreads();
        if (i + 1 < 17) { write2(i + 1); __syncthreads(); }
    }
    LAS float* cmb = (LAS float*)(lds + wave * AS_CMB);
    if (ks == 1) { cmb[lane] = m_run; cmb[64 + lane] = l_run;
#pragma unroll
        for (int r = 0; r < 16; ++r) { cmb[(2 + r) * 64 + lane] = o0[r]; cmb[(18 + r) * 64 + lane] = o1[r]; } }
    __syncthreads();
    if (ks == 0) {
#pragma unroll
        for (int k = 1; k < 2; ++k) { const LAS float* c = (const LAS float*)(lds + (qh + 2 * k) * AS_CMB);
            const float mk = c[lane], lk = c[64 + lane], mn = fmaxf(m_run, mk), fa = __builtin_amdgcn_exp2f(m_run - mn), fb = __builtin_amdgcn_exp2f(mk - mn);
            l_run = l_run * fa + lk * fb; m_run = mn;
#pragma unroll
            for (int r = 0; r < 16; ++r) { o0[r] = o0[r] * fa + c[(2 + r) * 64 + lane] * fb; o1[r] = o1[r] * fa + c[(18 + r) * 64 + lane] * fb; } }
        const float lt = l_run + __shfl_xor(l_run, 32); const float rl = 1.0f / lt;
        bf16_t* Y = (bf16_t*)(ws + WS_YCAT) + (size_t)qrow * (2 * D) + D + h * HD;
#pragma unroll
        for (int g = 0; g < 4; ++g) {
            u32x2 w0, w1; w0.x = cvt_pk_bf16(o0[4 * g] * rl, o0[4 * g + 1] * rl); w0.y = cvt_pk_bf16(o0[4 * g + 2] * rl, o0[4 * g + 3] * rl);
            w1.x = cvt_pk_bf16(o1[4 * g] * rl, o1[4 * g + 1] * rl); w1.y = cvt_pk_bf16(o1[4 * g + 2] * rl, o1[4 * g + 3] * rl);
            *(u32x2*)(Y + 8 * g + 4 * hi) = w0; *(u32x2*)(Y + 32 + 8 * g + 4 * hi) = w1; }
    }
    __syncthreads();
}

constexpr int LR_XCB = 0  , LR_XCF = 9216  , LR_A = LR_XCF + 64 * 68 * 4  , LR_B = LR_A + 16384, LR_SA = LR_B + 16384  , LR_SB = LR_SA + 2048, LR_HC = LR_SB + 2048  , LR_PC = LR_HC + 512, LR_END = LR_PC + 512;
__device__ __forceinline__ void lru_item(const Args& a, LAS unsigned char* lds, const int s, const int seg, const int hb, const int tid_in, const int lane_in, const int wave) {
    int tid = tid_in; asm volatile("" : "+v"(tid)); const int lane = tid & 63;
    unsigned char* ws = a.ws;
    const bf16_t* XR = (const bf16_t*)(ws + WS_XR); const bf16_t* GATE = (const bf16_t*)(ws + WS_GATE); bf16_t* YL = (bf16_t*)(ws + WS_YCAT); bf16_t* PB = (bf16_t*)(ws + WS_PB); bf16_t* HL = (bf16_t*)(ws + WS_HL);
    const bool fin = s != 0;
    const int nch = s == 0 ? SEGCH : 1, row0 = s == 0 ? 0 : MP + (s - 1) * 64, tb = s == 0 ? seg * SEGLEN : 0;
    const int c0 = hb * 64;
    const int ct = tid >> 3, cg8 = tid & 7, cch = c0 + cg8 * 8;
    float cw[4][8], cb[8];
#pragma unroll
    for (int j = 0; j < 4; ++j) { const f32x4 w0 = *(const f32x4*)(a.in[11] + j * D + cch), w1 = *(const f32x4*)(a.in[11] + j * D + cch + 4);
#pragma unroll
        for (int i = 0; i < 4; ++i) { cw[j][i] = w0[i]; cw[j][4 + i] = w1[i]; } }
    { const f32x4 b0 = *(const f32x4*)(a.in[12] + cch), b1 = *(const f32x4*)(a.in[12] + cch + 4);
#pragma unroll
      for (int i = 0; i < 4; ++i) { cb[i] = b0[i]; cb[4 + i] = b1[i]; } }
    const int jt = wave & 3, mt0 = 2 * (wave >> 2), fr = lane & 15, fq = lane >> 4;
    bf16x8 brg[2], big[2];
    { const float* wr_ = a.in[13] + (size_t)hb * 4096 + jt * 16 + fr; const float* wi_ = a.in[15] + (size_t)hb * 4096 + jt * 16 + fr;
#pragma unroll
      for (int ks = 0; ks < 2; ++ks) { u32x4 r, q; float tr[8], ti[8];
#pragma unroll
          for (int e = 0; e < 8; ++e) { const int i = 32 * ks + 8 * fq + e; tr[e] = wr_[i * 64]; ti[e] = wi_[i * 64]; }
          r.x = cvt_pk_bf16(tr[0], tr[1]); r.y = cvt_pk_bf16(tr[2], tr[3]); r.z = cvt_pk_bf16(tr[4], tr[5]); r.w = cvt_pk_bf16(tr[6], tr[7]);
          q.x = cvt_pk_bf16(ti[0], ti[1]); q.y = cvt_pk_bf16(ti[2], ti[3]); q.z = cvt_pk_bf16(ti[4], ti[5]); q.w = cvt_pk_bf16(ti[6], ti[7]);
          brg[ks] = __builtin_bit_cast(bf16x8, r); big[ks] = __builtin_bit_cast(bf16x8, q); } }
    const int ej = c0 + jt * 16 + fr;
    const float e_brg = a.in[14][ej], e_big = a.in[16][ej];
    float e_ls; { const float lam = a.in[17][ej]; e_ls = 8.0f * (fminf(lam, 0.f) - log1pf(expf(-fabsf(lam)))) * L2E; }
    const int sj = tid & 63, sseg = tid >> 6;
    LAS bf16_t* xcb = (LAS bf16_t*)(lds + LR_XCB); LAS float* xcf = (LAS float*)(lds + LR_XCF); LAS float* LA = (LAS float*)(lds + LR_A); LAS float* LB = (LAS float*)(lds + LR_B);
    LAS float* SA = (LAS float*)(lds + LR_SA); LAS float* SB = (LAS float*)(lds + LR_SB); LAS float* HC = (LAS float*)(lds + LR_HC); LAS float* PC = (LAS float*)(lds + LR_PC);
    if (tid < 64) { HC[tid] = fin ? a.in[6][(size_t)(s - 1) * D + c0 + tid] : 0.f; PC[tid] = 1.f; }
    u32x4 xr[4]; bf16_t gt[8];
    auto prefetch = [&](int k) {
        const int t0 = tb + k * 64 + ct;
#pragma unroll
        for (int j = 0; j < 4; ++j) { const int tt = t0 + j - 3;
            if (tt >= 0) xr[j] = *(const u32x4*)(XR + (size_t)(row0 + tt) * D + cch); else xr[j] = (u32x4){0u, 0u, 0u, 0u}; }
        if (fin) {
#pragma unroll
            for (int i = 0; i < 8; ++i) gt[i] = GATE[(size_t)(row0 + tb + k * 64 + sseg * 8 + i) * D + c0 + sj]; }
    };
    prefetch(0);
    for (int k = 0; k < nch; ++k) {
        { float xc[8];
#pragma unroll
          for (int i = 0; i < 8; ++i) xc[i] = cb[i];
#pragma unroll
          for (int j = 0; j < 4; ++j) { float xv[8]; const int tt = tb + k * 64 + ct + j - 3;
              if (fin && tt < 0) { const float* sp = a.in[5] + ((size_t)(s - 1) * 3 + (tt + 3)) * D + cch; const f32x4 q0 = *(const f32x4*)sp, q1 = *(const f32x4*)(sp + 4);
#pragma unroll
                  for (int i = 0; i < 4; ++i) { xv[i] = q0[i]; xv[4 + i] = q1[i]; } }
              else { const u32x4 w = xr[j];
                  xv[0] = __uint_as_float(w.x << 16); xv[1] = __uint_as_float(w.x & 0xffff0000u); xv[2] = __uint_as_float(w.y << 16); xv[3] = __uint_as_float(w.y & 0xffff0000u);
                  xv[4] = __uint_as_float(w.z << 16); xv[5] = __uint_as_float(w.z & 0xffff0000u); xv[6] = __uint_as_float(w.w << 16); xv[7] = __uint_as_float(w.w & 0xffff0000u); }
#pragma unroll
              for (int i = 0; i < 8; ++i) xc[i] += xv[i] * cw[j][i]; }
          u32x4 pw; pw.x = cvt_pk_bf16(xc[0], xc[1]); pw.y = cvt_pk_bf16(xc[2], xc[3]); pw.z = cvt_pk_bf16(xc[4], xc[5]); pw.w = cvt_pk_bf16(xc[6], xc[7]);
          *(LAS u32x4*)(xcb + ct * 72 + cg8 * 8) = pw;
          *(LAS f32x4*)(xcf + ct * 68 + cg8 * 8) = (f32x4){xc[0], xc[1], xc[2], xc[3]}; *(LAS f32x4*)(xcf + ct * 68 + cg8 * 8 + 4) = (f32x4){xc[4], xc[5], xc[6], xc[7]}; }
        bf16_t gcur[8];
#pragma unroll
        for (int i = 0; i < 8; ++i) gcur[i] = gt[i];
        __syncthreads();
        if (k + 1 < nch) prefetch(k + 1);
#pragma unroll
        for (int mi = 0; mi < 2; ++mi) { const int mt = mt0 + mi; f32x4 pr = {0.f, 0.f, 0.f, 0.f}, pi = {0.f, 0.f, 0.f, 0.f};
#pragma unroll
            for (int ks = 0; ks < 2; ++ks) { const bf16x8 af = *(const LAS bf16x8*)(xcb + (mt * 16 + fr) * 72 + ks * 32 + fq * 8);
                pr = __builtin_amdgcn_mfma_f32_16x16x32_bf16(af, brg[ks], pr, 0, 0, 0); pi = __builtin_amdgcn_mfma_f32_16x16x32_bf16(af, big[ks], pi, 0, 0, 0); }
#pragma unroll
            for (int i = 0; i < 4; ++i) { const int t = mt * 16 + 4 * fq + i;
                const float r = fast_sigmoid(pr[i] + e_brg), ig = fast_sigmoid(pi[i] + e_big);
                const float av = __builtin_amdgcn_exp2f(r * e_ls);
                float mult = sqrtf(fmaxf(1.f - av * av, 0.f));
                if (!fin && tb + k * 64 + t == 0) mult = 1.f;
                const float xcv = xcf[t * 68 + jt * 16 + fr];
                LA[t * 64 + jt * 16 + fr] = av; LB[t * 64 + jt * 16 + fr] = mult * ig * xcv; } }
        __syncthreads();
        float av[8], bv[8];
        { float Ap = 1.f, Bp = 0.f;
#pragma unroll
          for (int i = 0; i < 8; ++i) { av[i] = LA[(sseg * 8 + i) * 64 + sj]; bv[i] = LB[(sseg * 8 + i) * 64 + sj]; Bp = av[i] * Bp + bv[i]; Ap *= av[i]; }
          SA[sseg * 64 + sj] = Ap; SB[sseg * 64 + sj] = Bp; }
        __syncthreads();
        { float hv = HC[(k & 1) * 64 + sj], pv = PC[(k & 1) * 64 + sj];
#pragma unroll
          for (int q = 0; q < 8; ++q) { const float A_ = SA[q * 64 + sj], B_ = SB[q * 64 + sj]; if (q < sseg) { hv = A_ * hv + B_; pv *= A_; } }
          const size_t ob = (size_t)(row0 + tb + k * 64 + sseg * 8) * D + c0 + sj;
#pragma unroll
          for (int i = 0; i < 8; ++i) { hv = av[i] * hv + bv[i]; pv *= av[i];
              if (fin) { const float g = __uint_as_float((unsigned)gcur[i] << 16); YL[(size_t)(row0 + tb + k * 64 + sseg * 8 + i) * (2 * D) + c0 + sj] = (bf16_t)(cvt_pk_bf16(hv * g, 0.f) & 0xffffu); }
              else { ((unsigned*)HL)[ob + (size_t)i * D] = cvt_pk_bf16(hv, pv); } }
          if (sseg == 7) { HC[((k + 1) & 1) * 64 + sj] = hv; PC[((k + 1) & 1) * 64 + sj] = pv;
              if (k + 1 == nch) { if (fin) a.out[O_HS + (size_t)(s - 1) * D + c0 + sj] = hv;
                  else { float* ag = (float*)(ws + WS_AGG) + (size_t)seg * 2048 + c0 + sj; ag[0] = pv; ag[1024] = hv; } } } }
    }
    if (!fin) {
        asm volatile("s_waitcnt vmcnt(0)" ::: "memory"); __syncthreads();
        if (tid == 0) { __builtin_amdgcn_fence(__ATOMIC_RELEASE, "agent"); asm volatile("s_waitcnt vmcnt(0)" ::: "memory");
            __hip_atomic_store((unsigned*)(ws + WS_FLAG) + seg * 16 + hb, 1u, __ATOMIC_RELAXED, __HIP_MEMORY_SCOPE_AGENT); } }
    __syncthreads();
}
__device__ __forceinline__ void lru_fix_item(const Args& a, const int seg, const int hb, const int tid_in) {
    int tid = tid_in; asm volatile("" : "+v"(tid));
    unsigned char* ws = a.ws;
    if (tid == 0) { unsigned* fl = (unsigned*)(ws + WS_FLAG) + hb;
        for (int q = 0; q <= seg; ++q) while (__hip_atomic_load(fl + q * 16, __ATOMIC_RELAXED, __HIP_MEMORY_SCOPE_AGENT) == 0u) __builtin_amdgcn_s_sleep(4);
        __builtin_amdgcn_fence(__ATOMIC_ACQUIRE, "agent"); asm volatile("s_waitcnt vmcnt(0)" ::: "memory"); }
    __syncthreads();
    const int cg8 = tid & 7, cch = hb * 64 + cg8 * 8, r0 = tid >> 3;
    float hin[8];
#pragma unroll
    for (int i = 0; i < 8; ++i) hin[i] = 0.f;
    const float* ag = (const float*)(ws + WS_AGG) + cch;
    for (int q = 0; q < seg; ++q) { const f32x4 A0 = *(const f32x4*)(ag + q * 2048), A1 = *(const f32x4*)(ag + q * 2048 + 4), B0 = *(const f32x4*)(ag + q * 2048 + 1024), B1 = *(const f32x4*)(ag + q * 2048 + 1028);
#pragma unroll
        for (int i = 0; i < 4; ++i) { hin[i] = A0[i] * hin[i] + B0[i]; hin[4 + i] = A1[i] * hin[4 + i] + B1[i]; } }
    if (seg == NSEG - 1 && r0 == 0) { const int q = seg; const f32x4 A0 = *(const f32x4*)(ag + q * 2048), A1 = *(const f32x4*)(ag + q * 2048 + 4), B0 = *(const f32x4*)(ag + q * 2048 + 1024), B1 = *(const f32x4*)(ag + q * 2048 + 1028);
        f32x4 h0, h1;
#pragma unroll
        for (int i = 0; i < 4; ++i) { h0[i] = A0[i] * hin[i] + B0[i]; h1[i] = A1[i] * hin[4 + i] + B1[i]; }
        *(f32x4*)(a.out + O_HP + cch) = h0; *(f32x4*)(a.out + O_HP + cch + 4) = h1; }
    bf16_t* YL = (bf16_t*)(ws + WS_YCAT); const bf16_t* HL = (const bf16_t*)(ws + WS_HL); const bf16_t* PB = (const bf16_t*)(ws + WS_PB); const bf16_t* GATE = (const bf16_t*)(ws + WS_GATE);
#pragma unroll 4
    for (int i = 0; i < SEGLEN / 64; ++i) { const size_t off = (size_t)(seg * SEGLEN + r0 + 64 * i) * D + cch;
        const unsigned* hp = (const unsigned*)HL + off; const u32x4 a0 = *(const u32x4*)hp, a1 = *(const u32x4*)(hp + 4), gg = *(const u32x4*)(GATE + off);
        const unsigned aw[8] = {a0.x, a0.y, a0.z, a0.w, a1.x, a1.y, a1.z, a1.w}; const unsigned* gw = (const unsigned*)&gg; u32x4 o; unsigned* ow = (unsigned*)&o;
#pragma unroll
        for (int e = 0; e < 4; ++e) { const float y0 = (__uint_as_float(aw[2 * e] << 16) + __uint_as_float(aw[2 * e] & 0xffff0000u) * hin[2 * e]) * __uint_as_float(gw[e] << 16);
            const float y1 = (__uint_as_float(aw[2 * e + 1] << 16) + __uint_as_float(aw[2 * e + 1] & 0xffff0000u) * hin[2 * e + 1]) * __uint_as_float(gw[e] & 0xffff0000u);
            ow[e] = cvt_pk_bf16(y0, y1); }
        *(u32x4*)(YL + (size_t)(seg * SEGLEN + r0 + 64 * i) * (2 * D) + cch) = o; }
}

__device__ __forceinline__ void norm_pass(const Args& a, LAS unsigned char* lds, int tid, int lane, int wave) {
    unsigned char* ws = a.ws; LAS float* red = (LAS float*)lds;
    for (int b = blockIdx.x; b < MP / 64; b += gridDim.x) {
#pragma unroll
        for (int kind = 1; kind < 2; ++kind) { const bf16_t* X = (const bf16_t*)(ws + WS_K); float mx = 0.f;
#pragma unroll
            for (int i = 0; i < 8; ++i) { const bf16_t* p = X + (size_t)(b * 64 + wave * 8 + i) * D + lane * 16; const u32x4 w0 = *(const u32x4*)p, w1 = *(const u32x4*)(p + 8); float sq = 0.f;
                const unsigned ww[8] = {w0.x, w0.y, w0.z, w0.w, w1.x, w1.y, w1.z, w1.w};
#pragma unroll
                for (int e = 0; e < 8; ++e) { const float lo = __uint_as_float(ww[e] << 16), hi = __uint_as_float(ww[e] & 0xffff0000u); sq += lo * lo + hi * hi; }
                sq += __shfl_xor(sq, 1); sq += __shfl_xor(sq, 2); mx = fmaxf(mx, sq); }
            if ((lane & 3) == 0) red[(wave * 2 + kind) * 16 + (lane >> 2)] = mx; }
        __syncthreads();
        if (tid >= 16 && tid < 32) { float m = 0.f;
#pragma unroll
            for (int w = 0; w < 8; ++w) m = fmaxf(m, red[(w * 2 + (tid >> 4)) * 16 + (tid & 15)]);
            ((float*)(ws + WS_N2))[b * 32 + tid] = m; }
        __syncthreads();
    }
}

#define XB_TMO      128
#define XB_XCNT(j)  (256  + 64 * (j))
#define XB_XSUB(j)  (1280 + 64 * (j))
#define XB_XGEN(j)  (2304 + 64 * (j))
#define XB_TOP      3328
#define XB_TOPGEN   3392
#define XCD_BAR_WORDS 3456
#define XB_SPIN_CAP (1u << 18)
__device__ __forceinline__ unsigned xb_ld(unsigned* p)              { return __hip_atomic_load(p, __ATOMIC_RELAXED, __HIP_MEMORY_SCOPE_AGENT); }
__device__ __forceinline__ unsigned xb_add(unsigned* p, unsigned v) { return __hip_atomic_fetch_add(p, v, __ATOMIC_RELAXED, __HIP_MEMORY_SCOPE_AGENT); }
__device__ __forceinline__ unsigned xb_xcc_id() { return (unsigned)__builtin_amdgcn_s_getreg((3 << 11) | 20) & 0xFu; }
#define XB_SPIN(cond, bar) do { unsigned _sp = 0; while (cond) { __builtin_amdgcn_s_sleep(1); \
    if ((++_sp & 255u) == 0u) { if (xb_ld(&(bar)[XB_TMO])) break; if (_sp > XB_SPIN_CAP) { atomicAdd(&(bar)[XB_TMO], 1u); break; } } } } while (0)
struct XcdBarrier { unsigned* bar; unsigned x; volatile LAS unsigned* st; };
__device__ __forceinline__ XcdBarrier xcd_barrier_post(unsigned* bar, volatile LAS unsigned* st) {
    XcdBarrier b; b.bar = bar; b.x = xb_xcc_id(); b.st = st;
    if (threadIdx.x == 0) (void)xb_add(&bar[XB_XCNT(b.x)], 1u);
    return b;
}
__device__ __forceinline__ void xcd_barrier_complete(unsigned* bar, unsigned x, unsigned& nloc, unsigned& nx) {
    const unsigned G = gridDim.x * gridDim.y * gridDim.z;
    unsigned sum, cnt, mine, sp = 0u;
    for (;;) {
        sum = 0u; cnt = 0u; mine = 0u;
#pragma unroll
        for (unsigned j = 0; j < 16; ++j) { const unsigned c = xb_ld(&bar[XB_XCNT(j)]); sum += c; cnt += (c > 0u) ? 1u : 0u; mine = (j == x) ? c : mine; }
        if (sum == G) break;
        __builtin_amdgcn_s_sleep(1);
        if ((++sp & 255u) == 0u) { if (xb_ld(&bar[XB_TMO])) break; if (sp > XB_SPIN_CAP) { atomicAdd(&bar[XB_TMO], 1u); break; } }
    }
    nloc = mine > 0u ? mine : 1u; nx = cnt > 0u ? cnt : 1u;
}
__device__ __forceinline__ void xcd_barrier(const XcdBarrier& b) {
    asm volatile("s_waitcnt vmcnt(0)" ::: "memory");
    __syncthreads();
    if (threadIdx.x == 0) {
        unsigned* bar = b.bar;
        __builtin_amdgcn_s_waitcnt(0);
        unsigned nloc = b.st[0], nx = b.st[1];
        if (nloc == 0u) { xcd_barrier_complete(bar, b.x, nloc, nx); b.st[0] = nloc; b.st[1] = nx; }
        const unsigned old = xb_add(&bar[XB_XSUB(b.x)], 1u);
        const unsigned gen = old / nloc;
        if (old + 1u == (gen + 1u) * nloc) {
            __builtin_amdgcn_fence(__ATOMIC_RELEASE, "agent");
            asm volatile("s_waitcnt vmcnt(0)" ::: "memory");
            const unsigned og = xb_add(&bar[XB_TOP], 1u);
            const unsigned tg = og / nx;
            if (og + 1u == (tg + 1u) * nx) xb_add(&bar[XB_TOPGEN], 1u);
            else XB_SPIN(xb_ld(&bar[XB_TOPGEN]) == tg, bar);
            __builtin_amdgcn_fence(__ATOMIC_ACQUIRE, "agent");
            xb_add(&bar[XB_XGEN(b.x)], 1u);
            asm volatile("s_waitcnt vmcnt(0)" ::: "memory");
        } else {
            XB_SPIN(xb_ld(&bar[XB_XGEN(b.x)]) == gen, bar);
            __builtin_amdgcn_fence(__ATOMIC_ACQUIRE, "agent");
            asm volatile("s_waitcnt vmcnt(0)" ::: "memory");
        }
    }
    __syncthreads();
}

__global__ void __launch_bounds__(512, 2) fwd_megakernel(Args a) {
    extern __shared__ __attribute__((aligned(16))) unsigned char lds_raw[];
    LAS unsigned char* lds = (LAS unsigned char*)lds_raw;
    cg::grid_group grid = cg::this_grid();
    const int tid = threadIdx.x, lane = tid & 63, wave = __builtin_amdgcn_readfirstlane(tid >> 6);
    unsigned char* ws = a.ws;
    const int lo = a.ph_lo, hi = a.ph_hi;
#define IN(k) (lo <= (k) && (k) < hi)
    { volatile LAS unsigned* st = (volatile LAS unsigned*)(lds + 144000); if (tid < 2) st[tid] = 0u; }
    __syncthreads();
    const XcdBarrier xbar = xcd_barrier_post((unsigned*)(ws + WS_BAR), (volatile LAS unsigned*)(lds + 144000));
#define SEAM(k) do { xcd_barrier(xbar); } while (0)
    if (a.ph_lo > 1000) grid.sync();
    if (IN(0)) { p0_phase(a, lds, tid, lane, wave); }
    SEAM(0);
    if (IN(1)) {
        pg8::Gemm g{(const bf16_t*)(ws + WS_XN), (const bf16_t*)(ws + WS_WIN), M, NIN, D}; pg8::StaticOrder S; S.init(M, NIN, gridDim.x, blockIdx.x);
        EpiIn E{(bf16_t*)(ws + WS_XR), (bf16_t*)(ws + WS_GATE), (bf16_t*)(ws + WS_Q), (bf16_t*)(ws + WS_K), (bf16_t*)(ws + WS_V), (bf16_t*)(ws + WS_G), a.out, a.in[10]};
        pg8::gemm_phase<EpiIn>(lds, g, S, E);
        if (blockIdx.x == gridDim.x - 1) prefix_task(a, lds, tid);
    }
    SEAM(1);
    if (IN(2)) {
        norm_pass(a, lds, tid, lane, wave);
        xcd_barrier(xbar);
        constexpr int N_LRUA = NSEG * 16, N_ATTP = 64 * 16, N_ATTS = 256, N_LRUS = 256, N_LRUB = NSEG * 16;
        constexpr int Q1 = N_LRUA, Q2 = Q1 + N_ATTP, Q3 = Q2 + N_ATTS, Q4 = Q3 + N_LRUS, NITEMS = Q4 + N_LRUB;
        LAS int* slot = (LAS int*)(lds + 140 * 1024);
        for (;;) {
            if (tid == 0) *slot = (int)atomicAdd((unsigned*)(ws + WS_CTL), 1u);
            __syncthreads();
            const int it0 = __builtin_amdgcn_readfirstlane(*slot);
            __syncthreads();
            if (it0 >= NITEMS) break;
            int it = it0;
            if (it0 >= Q1 && it0 < Q3) { const int idx = it0 - Q1, grp = (int)(((unsigned)idx * 52429u) >> 18), r = idx - grp * 5;
                it = r < 4 ? Q1 + grp * 4 + r : Q2 + grp; }
            if (it < Q1) lru_item(a, lds, 0, it >> 4, it & 15, tid, lane, wave);
            else if (it < Q2) { const int i = it - Q1; attn_unit(a, lds, 0, i & 15, 63 - (i >> 4), tid, lane, wave); }
            else if (it < Q3) { const int i = it - Q2; attn_sample_unit(a, lds, i & 15, i >> 4, tid, lane, wave); }
            else if (it < Q4) { const int i = it - Q3; lru_item(a, lds, 1 + (i >> 4), 0, i & 15, tid, lane, wave); }
            else { const int i = it - Q4; lru_fix_item(a, i >> 4, i & 15, tid); }
        }
    }
    SEAM(2);
    if (IN(3)) {
        pg8::Gemm g{(const bf16_t*)(ws + WS_YCAT), (const bf16_t*)(ws + WS_WCAT), M, D, 2 * D}; pg8::StaticOrder S; S.init(M, D, gridDim.x, blockIdx.x);
        EpiMerge E{(const bf16_t*)(ws + WS_G), (bf16_t*)(ws + WS_MIXED)};
        pg8::gemm_phase<EpiMerge>(lds, g, S, E);
    }
    SEAM(3);
    if (IN(4)) {
        pg8::Gemm g{(const bf16_t*)(ws + WS_MIXED), (const bf16_t*)(ws + WS_WOUT), M, D, D}; pg8::StaticOrder S; S.init(M, D, gridDim.x, blockIdx.x);
        EpiOut E{a.in[0], a.in[1], (bf16_t*)(ws + WS_X2), (float*)(ws + WS_RSS2)};
        pg8::gemm_phase<EpiOut>(lds, g, S, E);
    }
    SEAM(4);
    if (IN(5)) {
        pg8::Gemm g{(const bf16_t*)(ws + WS_X2), (const bf16_t*)(ws + WS_WFFI), M, 2 * DFF, D}; pg8::StaticOrder S; S.init(M, 2 * DFF, gridDim.x, blockIdx.x);
        EpiFfnIn E{(const float*)(ws + WS_RSS2), (bf16_t*)(ws + WS_HFF)};
        pg8::gemm_phase<EpiFfnIn>(lds, g, S, E);
    }
    SEAM(5);
    if (IN(6)) {
        pg8::Gemm g{(const bf16_t*)(ws + WS_HFF), (const bf16_t*)(ws + WS_WFFO), M, D, DFF}; pg8::StaticOrder S; S.init(M, D, gridDim.x, blockIdx.x);
        EpiFfnOut E{(const bf16_t*)(ws + WS_X2), (bf16_t*)(ws + WS_XG), (float*)(ws + WS_RSS3)};
        pg8::gemm_phase<EpiFfnOut>(lds, g, S, E);
    }
    SEAM(6);
    if (IN(7)) {
        const float* rss = (const float*)(ws + WS_RSS3); const float* gf = a.in[24];
        f32x4 gv[4];
#pragma unroll
        for (int j = 0; j < 4; ++j) gv[j] = *(const f32x4*)(gf + 4 * lane + 256 * j);
        for (int row = blockIdx.x * 8 + wave; row < M; row += gridDim.x * 8) {
            const float rstd = 1.0f / sqrtf(rss[row] * (1.f / D) + EPS); float* y = a.out + O_Y + (size_t)row * D + 4 * lane; const bf16_t* x3 = (const bf16_t*)(ws + WS_XG) + (size_t)row * D + 4 * lane;
#pragma unroll
            for (int j = 0; j < 4; ++j) { const u32x2 w = *(const u32x2*)(x3 + 256 * j);
                f32x4 v = {__uint_as_float(w.x << 16), __uint_as_float(w.x & 0xffff0000u), __uint_as_float(w.y << 16), __uint_as_float(w.y & 0xffff0000u)};
                *(f32x4*)(y + 256 * j) = v * rstd * gv[j]; }
        }
    }
#undef IN
#undef SEAM
}

extern "C" void kernel_launch(void* const* d_in, const int* in_sizes, int n_in, void* d_out, int out_size, void* d_ws, size_t ws_size, hipStream_t stream) {
    static int grid = 0;
    if (grid == 0) {
        if (n_in != 25 || (size_t)out_size != O_END || ws_size < WS_END) { fprintf(stderr, "kernel_launch: unexpected shapes: n_in %d out %d (want %zu) ws %zu (want %zu)\n", n_in, out_size, (size_t)O_END, ws_size, (size_t)WS_END); grid = -1; return; }
        int dev = 0, cus = 0, per_cu = 0;
        (void)hipGetDevice(&dev); (void)hipDeviceGetAttribute(&cus, hipDeviceAttributeMultiprocessorCount, dev);
        if (hipFuncSetAttribute((const void*)fwd_megakernel, hipFuncAttributeMaxDynamicSharedMemorySize, LDS_BYTES) != hipSuccess) { fprintf(stderr, "kernel_launch: hipFuncSetAttribute failed\n"); grid = -1; return; }
        if (hipOccupancyMaxActiveBlocksPerMultiprocessor(&per_cu, (const void*)fwd_megakernel, 512, LDS_BYTES) != hipSuccess || per_cu < 1) { fprintf(stderr, "kernel_launch: occupancy query failed (%d)\n", per_cu); (void)hipGetLastError(); per_cu = 1; }
        grid = cus * 1;
        fprintf(stderr, "kernel_launch: cus %d per_cu %d grid %d\n", cus, per_cu, grid);
    }
    if (grid < 0) return;
    Args a{};
    for (int i = 0; i < 25; ++i) a.in[i] = (const float*)d_in[i];
    a.out = (float*)d_out; a.ws = (unsigned char*)d_ws; a.ph_lo = 0; a.ph_hi = 8;
    if (hipMemsetAsync((char*)d_ws + WS_BAR, 0, 16 * 1024, stream) != hipSuccess) { fprintf(stderr, "kernel_launch: memset failed\n"); return; }
    void* args[] = {&a};
    hipError_t e = hipLaunchCooperativeKernel((const void*)fwd_megakernel, dim3(grid), dim3(512), args, LDS_BYTES, stream);
    if (e != hipSuccess) fprintf(stderr, "kernel_launch: cooperative launch failed: %s (grid %d)\n", hipGetErrorString(e), grid);
}
```
